# Optimizing an MI355X kernel written in HIP

```python
import math
import jax, jax.numpy as jnp
from jax import lax
import numpy as np

D_MODEL = 1024
BATCH = 4
SEQ = 4096
DEPTH = 1

NORM_EPS = 1e-6
N_MOD = 6
MLA_HEADS = 8
MLA_Q_LORA = 768
MLA_KV_LORA = 256
MLA_NOPE = 64
MLA_ROPE = 32
MLA_QK = MLA_NOPE + MLA_ROPE
MLA_VDIM = 64
MLA_WIDTH = MLA_HEADS * MLA_VDIM
ROPE_THETA = 10000.0
ATTN_QBLOCK = 128
MOBA_HEADS = 8
MOBA_HDIM = 64
MOBA_WIDTH = MOBA_HEADS * MOBA_HDIM
MOBA_BLOCK = 256
MOBA_TOPK = 3
MOBA_QBLOCK = 32
D_MIX = MLA_WIDTH + MOBA_WIDTH
IN_WIDTHS = (MLA_Q_LORA, MLA_KV_LORA, MLA_ROPE, MOBA_WIDTH, MOBA_WIDTH, MOBA_WIDTH)
D_IN = sum(IN_WIDTHS)
REL_BUCKETS = 32
REL_MAX_DIST = 1024
PEER_NKEYS = 128
PEER_EXPERTS = PEER_NKEYS * PEER_NKEYS
PEER_HEADS = 8
PEER_TOPK = 16
PEER_DKEY = 128
PEER_HALF = PEER_DKEY // 2
PEER_TBLOCK = 128

kernel_name = "hymba_mla_moba_peer_adaln_layer"


def rmsnorm(x, g):
    xf = x.astype(jnp.float32)
    y = xf * lax.rsqrt(jnp.mean(xf * xf, axis=-1, keepdims=True) + NORM_EPS)
    return (y * g.astype(jnp.float32)).astype(x.dtype)


def rope(x, positions):
    half = x.shape[-1] // 2
    inv = ROPE_THETA ** (-jnp.arange(half, dtype=jnp.float32) / half)
    ang = positions.astype(jnp.float32)[:, :, None, None] * inv
    cos, sin = jnp.cos(ang), jnp.sin(ang)
    xf = x.astype(jnp.float32)
    x1, x2 = xf[..., :half], xf[..., half:]
    return jnp.concatenate([x1 * cos - x2 * sin, x2 * cos + x1 * sin], -1).astype(x.dtype)


def t5_bucket(dist):
    n = jnp.maximum(dist, 0)
    max_exact = REL_BUCKETS // 2
    nf = jnp.maximum(n, max_exact).astype(jnp.float32)
    large = max_exact + (jnp.log(nf / max_exact) / math.log(REL_MAX_DIST / max_exact)
                         * (REL_BUCKETS - max_exact)).astype(jnp.int32)
    large = jnp.minimum(large, REL_BUCKETS - 1)
    return jnp.where(n < max_exact, n, large)


def causal_attention(q, k, v):
    B, S, H, D = q.shape
    scale = D ** -0.5
    nq = S // ATTN_QBLOCK
    qb = q.reshape(B, nq, ATTN_QBLOCK, H, D).transpose(1, 0, 2, 3, 4)
    k_idx = jnp.arange(S)

    def one(args):
        qc, blk = args
        s = jnp.einsum('bqhd,bkhd->bhqk', qc, k).astype(jnp.float32) * scale
        q_idx = blk * ATTN_QBLOCK + jnp.arange(ATTN_QBLOCK)
        s = jnp.where(k_idx[None, :] <= q_idx[:, None], s, -jnp.inf)
        p = jax.nn.softmax(s, axis=-1).astype(v.dtype)
        return jnp.einsum('bhqk,bkhd->bqhd', p, v)

    o = lax.map(one, (qb, jnp.arange(nq)))
    return o.transpose(1, 0, 2, 3, 4).reshape(B, S, H, v.shape[-1])


def mla_group(c_q, c_kv, k_rope, positions, g_qa, w_uq, g_kva, w_ukv):
    B, S, _ = c_q.shape
    q = (rmsnorm(c_q, g_qa) @ w_uq).reshape(B, S, MLA_HEADS, MLA_QK)
    kv = (rmsnorm(c_kv, g_kva) @ w_ukv).reshape(B, S, MLA_HEADS, MLA_NOPE + MLA_VDIM)
    k_nope, v = kv[..., :MLA_NOPE], kv[..., MLA_NOPE:]
    q = jnp.concatenate([q[..., :MLA_NOPE], rope(q[..., MLA_NOPE:], positions)], -1)
    k_r = rope(k_rope[:, :, None, :], positions)
    k = jnp.concatenate([k_nope, jnp.broadcast_to(k_r, (B, S, MLA_HEADS, MLA_ROPE))], -1)
    return causal_attention(q, k, v).reshape(B, S, MLA_WIDTH)


def moba_group(q, k, v, rel_bias):
    B, S, _ = q.shape
    H, Dh, BS = MOBA_HEADS, MOBA_HDIM, MOBA_BLOCK
    q, k, v = (t.reshape(B, S, H, Dh).transpose(0, 2, 1, 3) for t in (q, k, v))
    nb = -(-S // BS)
    pad = nb * BS - S
    kb = jnp.pad(k, ((0, 0), (0, 0), (0, pad), (0, 0))).reshape(B, H, nb, BS, Dh)
    vb = jnp.pad(v, ((0, 0), (0, 0), (0, pad), (0, 0))).reshape(B, H, nb, BS, Dh)
    kmean = jnp.mean(kb, axis=3)
    n_sel = min(MOBA_TOPK, nb)
    scale = Dh ** -0.5
    bi = jnp.arange(B)[:, None, None, None]
    hi = jnp.arange(H)[None, :, None, None]
    hi5 = jnp.arange(H)[:, None, None, None]
    bias_hb = rel_bias.T.astype(jnp.float32)
    t_blk = jnp.arange(BS)
    nq = S // MOBA_QBLOCK
    qb = q.reshape(B, H, nq, MOBA_QBLOCK, Dh).transpose(2, 0, 1, 3, 4)

    def one(args):
        qc, blk = args
        q_idx = blk * MOBA_QBLOCK + jnp.arange(MOBA_QBLOCK)
        own = (blk * MOBA_QBLOCK) // BS
        gate = jnp.einsum('bhqd,bhnd->bhqn', qc, kmean).astype(jnp.float32)
        gate = jnp.where(jnp.arange(nb) < own, gate, -jnp.inf)
        _, sel = lax.top_k(gate, n_sel)
        slot_ok = jnp.arange(n_sel) < own
        k_sel = kb[bi, hi, sel]
        v_sel = vb[bi, hi, sel]
        s_sel = jnp.einsum('bhqd,bhqntd->bhqnt', qc, k_sel).astype(jnp.float32) * scale
        k_pos = sel[..., None] * BS + t_blk
        dist = q_idx[None, None, :, None, None] - k_pos
        s_sel = s_sel + bias_hb[hi5, t5_bucket(dist)]
        s_sel = jnp.where(slot_ok[:, None], s_sel, -jnp.inf)
        k_own = lax.dynamic_slice_in_dim(kb, own, 1, axis=2)[:, :, 0]
        v_own = lax.dynamic_slice_in_dim(vb, own, 1, axis=2)[:, :, 0]
        d_own = q_idx[:, None] - (own * BS + t_blk)[None, :]
        s_own = jnp.einsum('bhqd,bhtd->bhqt', qc, k_own).astype(jnp.float32) * scale
        s_own = s_own + bias_hb[:, t5_bucket(d_own)]
        s_own = jnp.where(d_own >= 0, s_own, -jnp.inf)
        s_all = jnp.concatenate([s_sel.reshape(B, H, MOBA_QBLOCK, n_sel * BS), s_own], -1)
        p = jax.nn.softmax(s_all, axis=-1).astype(v.dtype)
        p_sel = p[..., :n_sel * BS].reshape(B, H, MOBA_QBLOCK, n_sel, BS)
        p_own = p[..., n_sel * BS:]
        return (jnp.einsum('bhqnt,bhqntd->bhqd', p_sel, v_sel)
                + jnp.einsum('bhqt,bhtd->bhqd', p_own, v_own))

    o = lax.map(one, (qb, jnp.arange(nq)))
    o = o.transpose(1, 0, 3, 2, 4).reshape(B, S, H * Dh)
    return o


def peer_ffn(h, w_pq, sub_keys, u_tab, v_tab):
    B, S, D = h.shape
    K = PEER_TOPK
    q = (h @ w_pq).reshape(B, S, PEER_HEADS, 2, PEER_HALF)
    s = jnp.einsum('bshpd,hpnd->bshpn', q, sub_keys).astype(jnp.float32)
    s_top, i_top = lax.top_k(s, K)
    cand = (s_top[..., 0, :, None] + s_top[..., 1, None, :]).reshape(B, S, PEER_HEADS, K * K)
    cand_idx = (i_top[..., 0, :, None] * PEER_NKEYS + i_top[..., 1, None, :]).reshape(B, S, PEER_HEADS, K * K)
    best, pos = lax.top_k(cand, K)
    expert = jnp.take_along_axis(cand_idx, pos, axis=-1)
    gate = jax.nn.softmax(best, axis=-1).astype(h.dtype)
    nt = S // PEER_TBLOCK
    hc = h.reshape(B, nt, PEER_TBLOCK, D).transpose(1, 0, 2, 3)
    ec = expert.reshape(B, nt, PEER_TBLOCK, PEER_HEADS, K).transpose(1, 0, 2, 3, 4)
    gc = gate.reshape(B, nt, PEER_TBLOCK, PEER_HEADS, K).transpose(1, 0, 2, 3, 4)

    def one(args):
        hb, eb, gb = args
        a = jnp.einsum('btd,bthkd->bthk', hb, u_tab[eb])
        a = jax.nn.gelu(a, approximate=False) * gb
        return jnp.einsum('bthk,bthkd->btd', a, v_tab[eb])

    y = lax.map(one, (hc, ec, gc))
    return y.transpose(1, 0, 2, 3).reshape(B, S, D)


def setup_inputs(seed: int = 0) -> dict:
    key = jax.random.key(seed)
    ks = jax.random.split(key, 20)
    f32 = jnp.float32

    def nrm(k, shape, scale):
        return jax.random.normal(k, shape, f32) * scale

    def gain(k, shape):
        return 1.0 + 0.02 * jax.random.normal(k, shape, f32)

    L, D = DEPTH, D_MODEL
    offset = jax.random.randint(ks[2], (BATCH, 1), 0, 1024, dtype=jnp.int32)
    return {
        "x": nrm(ks[0], (BATCH, SEQ, D), 1.0),
        "c": nrm(ks[1], (BATCH, D), 1.0),
        "positions": (jnp.arange(SEQ, dtype=jnp.int32)[None, :] + offset).astype(jnp.int32),
        "w_ada": nrm(ks[3], (L, D, N_MOD * D), 0.5 * D ** -0.5),
        "b_ada": nrm(ks[4], (L, N_MOD * D), 0.02),
        "g_mix": gain(ks[5], (L, D)),
        "w_in": nrm(ks[6], (L, D, D_IN), D ** -0.5),
        "g_qa": gain(ks[7], (L, MLA_Q_LORA)),
        "w_uq": nrm(ks[8], (L, MLA_Q_LORA, MLA_HEADS * MLA_QK), MLA_Q_LORA ** -0.5),
        "g_kva": gain(ks[9], (L, MLA_KV_LORA)),
        "w_ukv": nrm(ks[10], (L, MLA_KV_LORA, MLA_HEADS * (MLA_NOPE + MLA_VDIM)), MLA_KV_LORA ** -0.5),
        "rel_bias": nrm(ks[11], (REL_BUCKETS, MOBA_HEADS), 0.5),
        "w_out": nrm(ks[12], (L, D_MIX, D), D_MIX ** -0.5),
        "g_ffn": gain(ks[13], (L, D)),
        "w_pq": nrm(ks[14], (L, D, PEER_HEADS * PEER_DKEY), D ** -0.5),
        "peer_keys": nrm(ks[15], (L, PEER_HEADS, 2, PEER_NKEYS, PEER_HALF), PEER_HALF ** -0.5),
        "peer_u": nrm(ks[16], (L, PEER_EXPERTS, D), D ** -0.5),
        "peer_v": nrm(ks[17], (L, PEER_EXPERTS, D), PEER_HEADS ** -0.5),
        "g_final": gain(ks[18], (D,)),
    }


def reference(x, c, positions, w_ada, b_ada, g_mix, w_in, g_qa, w_uq, g_kva, w_ukv,
              rel_bias, w_out, g_ffn, w_pq, peer_keys, peer_u, peer_v, g_final):
    split_at = [int(s) for s in np.cumsum(IN_WIDTHS)[:-1]]
    for l in range(DEPTH):
        mod = (jax.nn.silu(c) @ w_ada[l] + b_ada[l])[:, None, :]
        sh_a, sc_a, gt_a, sh_f, sc_f, gt_f = jnp.split(mod, N_MOD, axis=-1)
        h = rmsnorm(x, g_mix[l]) * (1.0 + sc_a) + sh_a
        z = h @ w_in[l]
        c_q, c_kv, k_rope, mq, mk, mv = jnp.split(z, split_at, axis=-1)
        o_mla = mla_group(c_q, c_kv, k_rope, positions, g_qa[l], w_uq[l], g_kva[l], w_ukv[l])
        o_moba = moba_group(mq, mk, mv, rel_bias)
        y = jnp.concatenate([o_mla, o_moba], axis=-1) @ w_out[l]
        x = x + gt_a * y
        h = rmsnorm(x, g_ffn[l]) * (1.0 + sc_f) + sh_f
        x = x + gt_f * peer_ffn(h, w_pq[l], peer_keys[l], peer_u[l], peer_v[l])
    return rmsnorm(x, g_final)
```

```cpp
#include <hip/hip_runtime.h>
#include <cstdio>
#include <cstdint>
#include <math.h>

namespace pg8 {
#define PG8_LAS __attribute__((address_space(3)))
typedef unsigned short bf16_t;
typedef short bf16x8 __attribute__((ext_vector_type(8)));
typedef float f32x4 __attribute__((ext_vector_type(4)));
typedef unsigned u32x4 __attribute__((ext_vector_type(4)));
constexpr int BM = 256, BK = 64, HALF = 128, HTB = HALF * BK * 2  , STAGE_BYTES = 8 * HTB, NXCD = 8, WGM = 8;

__host__ __device__ __forceinline__ int lds_byte(int r, int c) { const int st = (r >> 4) * 2 + (c >> 5), rr = r & 15, cc = c & 31, ob = rr * 64 + cc * 2; return st * 1024 + (ob ^ (((ob >> 9) & 1) << 5)); }
__host__ __device__ __forceinline__ void stage_rc(int b, int& R, int& C) { const int st = b / 1024, sb = b % 1024, swz = sb ^ (((sb >> 9) & 1) << 5); R = (st >> 1) * 16 + swz / 64; C = (st & 1) * 32 + (swz % 64) / 2; }
__host__ __device__ __forceinline__ int perm32(int rho) { const int n = rho >> 4, i = rho & 15; return 8 * (i >> 2) + 4 * n + (i & 3); }

struct Unit { int pm, pn; };
struct Gemm { const bf16_t* A; const bf16_t* Bt; int M, N, K, lda; };

struct StaticOrder {
    int nM, nN, nwg, G, c;
    __host__ __device__ void init(int M, int N, int G_, int c_) { nM = M / BM; nN = N / BM; nwg = nM * nN; G = G_; c = c_; }
    __host__ __device__ bool next(int i, Unit& u) const {
        const long L = (long)i * G + c; if (L >= nwg) return false;
        int wgid = (int)L; { const int q = nwg / NXCD, r = nwg % NXCD, xcd = wgid % NXCD, off = wgid / NXCD; wgid = (xcd < r ? xcd * (q + 1) : r * (q + 1) + (xcd - r) * q) + off; }
        const int nig = WGM * nN, gid = wgid / nig, fm = gid * WGM, gsz = (nM - fm) < WGM ? (nM - fm) : WGM;
        u.pm = fm + ((wgid % nig) % gsz); u.pn = (wgid % nig) / gsz; return true;
    }
    __device__ __forceinline__ void a_ready(const Unit&) const {}
    __device__ __forceinline__ void done(const Unit&) const {}
};
template <class Epi, class Sched, bool ALIGN_EPI = false, bool SP2 = false>
__device__ __forceinline__ void gemm_phase(PG8_LAS unsigned char* lds, const Gemm g, const Sched& S, const Epi& E) {
    const int tid = threadIdx.x, wid = __builtin_amdgcn_readfirstlane(tid >> 6), lane = tid & 63, wr = wid >> 2, wc = wid & 3, fr = lane & 15, fq = lane >> 4;
    const int K = g.K, nt = K / BK;
    unsigned voffA[2], voffB[2];
#pragma unroll
    for (int i = 0; i < 2; ++i) { int R, C; stage_rc(tid * 16 + i * 8192, R, C); const int Rb = Epi::PERM ? ((R & ~31) + perm32(R & 31)) : R;
        voffA[i] = (unsigned)(R * g.lda + C) * 2u; voffB[i] = (unsigned)(Rb * K + C) * 2u; }
    const size_t kstep = (size_t)(BK * 2);
    const size_t hsB = (size_t)HALF * K * 2, hsA = (size_t)HALF * g.lda * 2;
    const size_t tsB = 2 * hsB, tsA = 2 * hsA;
    const unsigned ldsw = (unsigned)wid * 1024u;
    const int aoff = lds_byte(wr * 64 + fr, fq * 8), boff = lds_byte(wc * 32 + fr, fq * 8);
#define PG8_SA(b, h) (((b) * 2 + (h)) * HTB)
#define PG8_SB(b, h) ((4 + (b) * 2 + (h)) * HTB)
#define PG8_STAGE(bufoff, gbase, voff) do { _Pragma("unroll") for (int _i = 0; _i < 2; ++_i) \
        __builtin_amdgcn_global_load_lds((const unsigned*)((const char*)(gbase) + (voff)[_i]), (PG8_LAS unsigned*)(lds + (bufoff) + ldsw + _i * 8192), 16, 0, 0); } while (0)
#define PG8_LDA(dst, b, h) do { _Pragma("unroll") for (int m = 0; m < 4; ++m) _Pragma("unroll") for (int k = 0; k < 2; ++k) dst[m][k] = *(const PG8_LAS bf16x8*)(lds + PG8_SA(b, h) + aoff + m * 2048 + k * 1024); } while (0)
#define PG8_LDB(dst, b, h) do { _Pragma("unroll") for (int n = 0; n < 2; ++n) _Pragma("unroll") for (int k = 0; k < 2; ++k) dst[n][k] = *(const PG8_LAS bf16x8*)(lds + PG8_SB(b, h) + boff + n * 2048 + k * 1024); } while (0)
#define PG8_MMA(ai, bj, At, Bt) do { __builtin_amdgcn_s_setprio(1); _Pragma("unroll") for (int m = 0; m < 4; ++m) _Pragma("unroll") for (int n = 0; n < 2; ++n) _Pragma("unroll") for (int k = 0; k < 2; ++k) \
        acc[ai][bj][m][n] = __builtin_amdgcn_mfma_f32_16x16x32_bf16(Bt[n][k], At[m][k], acc[ai][bj][m][n], 0, 0, 0); __builtin_amdgcn_s_setprio(0); } while (0)
#define PG8_WAIT_V(n) asm volatile("s_waitcnt vmcnt(" #n ")" ::: "memory")
#define PG8_WAIT_L(n) asm volatile("s_waitcnt lgkmcnt(" #n ")" ::: "memory")
#define PG8_BAR __builtin_amdgcn_s_barrier()
#define PG8_SCHED __builtin_amdgcn_sched_barrier(0)
    Unit cur, nxt; int ui = 0;
    if (!S.next(0, cur)) return;
    f32x4 acc[2][2][4][2];
#pragma unroll
    for (int a = 0; a < 2; ++a)
#pragma unroll
        for (int b = 0; b < 2; ++b)
#pragma unroll
            for (int m = 0; m < 4; ++m)
#pragma unroll
                for (int n = 0; n < 2; ++n) acc[a][b][m][n] = (f32x4){0.f, 0.f, 0.f, 0.f};
    bf16x8 At[4][2], B0[2][2], B1[2][2];
    const char* cA = (const char*)g.A + (size_t)cur.pm * tsA; const char* cB = (const char*)g.Bt + (size_t)cur.pn * tsB;
    S.a_ready(cur);
    if constexpr (SP2) {
        PG8_STAGE(PG8_SB(0, 0), cB, voffB); PG8_STAGE(PG8_SB(0, 1), cB + hsB, voffB); PG8_STAGE(PG8_SA(0, 0), cA, voffA); PG8_STAGE(PG8_SA(0, 1), cA + hsA, voffA);
        if (wr == 1) PG8_BAR;
        PG8_WAIT_V(2); PG8_BAR;
        PG8_STAGE(PG8_SB(1, 0), cB + kstep, voffB); PG8_STAGE(PG8_SA(1, 0), cA + kstep, voffA); PG8_STAGE(PG8_SB(1, 1), cB + hsB + kstep, voffB);
        PG8_WAIT_V(6); PG8_BAR;
    } else {
        PG8_STAGE(PG8_SB(0, 0), cB, voffB); PG8_STAGE(PG8_SA(0, 0), cA, voffA); PG8_STAGE(PG8_SB(0, 1), cB + hsB, voffB); PG8_STAGE(PG8_SA(0, 1), cA + hsA, voffA);
        if (wr == 1) PG8_BAR;
        PG8_WAIT_V(4); PG8_BAR;
        PG8_STAGE(PG8_SB(1, 0), cB + kstep, voffB); PG8_STAGE(PG8_SA(1, 0), cA + kstep, voffA); PG8_STAGE(PG8_SB(1, 1), cB + hsB + kstep, voffB);
        PG8_WAIT_V(6); PG8_BAR;
    }
    for (;;) {
        const bool has_next = S.next(ui + 1, nxt);
        const char* nA = has_next ? (const char*)g.A + (size_t)nxt.pm * tsA : cA; const char* nB = has_next ? (const char*)g.Bt + (size_t)nxt.pn * tsB : cB;
        for (int t = 0; t < nt; t += 2) {
            const bool last = (t == nt - 2);
            const char* a1 = cA + (size_t)(t + 1) * kstep;
            const char* a2 = last ? nA : cA + (size_t)(t + 2) * kstep; const char* b2 = last ? nB : cB + (size_t)(t + 2) * kstep;
            const char* a3 = a2 + kstep; const char* b3 = b2 + kstep;
            if (last && has_next) S.a_ready(nxt);
            if constexpr (SP2) {
            PG8_LDB(B0, 0, 0); PG8_LDB(B1, 0, 1); PG8_SCHED; PG8_LDA(At, 0, 0); PG8_STAGE(PG8_SA(1, 1), a1 + hsA, voffA);
            PG8_WAIT_V(8); PG8_WAIT_L(0); PG8_BAR; PG8_MMA(0, 0, At, B0); PG8_MMA(0, 1, At, B1); PG8_BAR; PG8_SCHED;
            PG8_LDA(At, 0, 1); PG8_STAGE(PG8_SB(0, 0), b2, voffB); PG8_STAGE(PG8_SB(0, 1), b2 + hsB, voffB); PG8_STAGE(PG8_SA(0, 0), a2, voffA);
            PG8_WAIT_V(8); PG8_WAIT_L(0); PG8_BAR; PG8_MMA(1, 0, At, B0); PG8_MMA(1, 1, At, B1); PG8_BAR; PG8_SCHED;
            PG8_LDB(B0, 1, 0); PG8_LDB(B1, 1, 1); PG8_SCHED; PG8_LDA(At, 1, 0); PG8_STAGE(PG8_SA(0, 1), a2 + hsA, voffA);
            PG8_WAIT_V(8); PG8_WAIT_L(0); PG8_BAR; PG8_MMA(0, 0, At, B0); PG8_MMA(0, 1, At, B1); PG8_BAR; PG8_SCHED;
            PG8_LDA(At, 1, 1); PG8_STAGE(PG8_SB(1, 0), b3, voffB); PG8_STAGE(PG8_SB(1, 1), b3 + hsB, voffB); PG8_STAGE(PG8_SA(1, 0), a3, voffA);
            PG8_WAIT_V(8); PG8_WAIT_L(0); PG8_BAR; PG8_MMA(1, 0, At, B0); PG8_MMA(1, 1, At, B1); PG8_BAR; PG8_SCHED;
            } else {
            PG8_LDB(B0, 0, 0); PG8_SCHED; PG8_LDA(At, 0, 0); PG8_STAGE(PG8_SA(1, 1), a1 + hsA, voffA);
            PG8_WAIT_L(8); PG8_BAR; PG8_WAIT_L(0); PG8_MMA(0, 0, At, B0); PG8_BAR; PG8_SCHED;
            PG8_LDB(B1, 0, 1); PG8_STAGE(PG8_SB(0, 0), b2, voffB);
            PG8_BAR; PG8_WAIT_L(0); PG8_MMA(0, 1, At, B1); PG8_BAR;
            PG8_LDA(At, 0, 1); PG8_STAGE(PG8_SA(0, 0), a2, voffA);
            PG8_BAR; PG8_WAIT_L(0); PG8_MMA(1, 0, At, B0); PG8_BAR; PG8_SCHED;
            PG8_STAGE(PG8_SB(0, 1), b2 + hsB, voffB);
            PG8_WAIT_V(6); PG8_BAR; PG8_MMA(1, 1, At, B1); PG8_BAR;
            PG8_LDB(B0, 1, 0); PG8_SCHED; PG8_LDA(At, 1, 0); PG8_STAGE(PG8_SA(0, 1), a2 + hsA, voffA);
            PG8_WAIT_L(8); PG8_BAR; PG8_WAIT_L(0); PG8_MMA(0, 0, At, B0); PG8_BAR; PG8_SCHED;
            PG8_LDB(B1, 1, 1); PG8_STAGE(PG8_SB(1, 0), b3, voffB);
            PG8_BAR; PG8_WAIT_L(0); PG8_MMA(0, 1, At, B1); PG8_BAR;
            PG8_LDA(At, 1, 1); PG8_STAGE(PG8_SA(1, 0), a3, voffA);
            PG8_BAR; PG8_WAIT_L(0); PG8_MMA(1, 0, At, B0); PG8_BAR; PG8_SCHED;
            PG8_STAGE(PG8_SB(1, 1), b3 + hsB, voffB);
            PG8_WAIT_V(6); PG8_BAR; PG8_MMA(1, 1, At, B1); PG8_BAR;
            }
        }
        if constexpr (ALIGN_EPI) { if (wr == 0) PG8_BAR; }
        if constexpr (!Epi::AFTER_DRAIN) { E(acc, cur, wr, wc, fr, fq); S.done(cur); }
        if (!has_next) break;
#pragma unroll
        for (int a = 0; a < 2; ++a)
#pragma unroll
            for (int b = 0; b < 2; ++b)
#pragma unroll
                for (int m = 0; m < 4; ++m)
#pragma unroll
                    for (int n = 0; n < 2; ++n) acc[a][b][m][n] = (f32x4){0.f, 0.f, 0.f, 0.f};
        cur = nxt; cA = nA; cB = nB; ++ui;
        if constexpr (ALIGN_EPI) { if (wr == 1) PG8_BAR; }
    }
    PG8_WAIT_V(0);
    if constexpr (!ALIGN_EPI) { if (wr == 0) PG8_BAR; }
    PG8_BAR;
    if constexpr (Epi::AFTER_DRAIN) { E.fused(acc, cur, wr, wc, fr, fq, lds, wid, lane); S.done(cur); }
#undef PG8_SA
#undef PG8_SB
#undef PG8_STAGE
#undef PG8_LDA
#undef PG8_LDB
#undef PG8_MMA
#undef PG8_WAIT_V
#undef PG8_WAIT_L
#undef PG8_BAR
#undef PG8_SCHED
}
}


constexpr int NWAVES = 8;
constexpr int NB = 4, S = 4096, D = 1024, T = NB * S;
constexpr int NZ = 2816;
constexpr float EPS = 1e-6f;
constexpr float LOG2E = 1.4426950408889634f;
constexpr float QS_MLA = 0.10206207261596575f * LOG2E;
constexpr float QS_MOBA = 0.125f * LOG2E;
#ifndef MK_LAUNCHES
#define MK_LAUNCHES 1

#endif
constexpr int NPHASE = 15;

constexpr size_t MiB = 1u << 20;
constexpr size_t WS_CTL = 0, CTL_ZERO_BYTES = 1 * MiB;
constexpr int CW_BAR = 4096;
constexpr size_t OFF_SSQ_Q = 256 * 1024, OFF_SSQ_KV = 320 * 1024, OFF_SSQ_1 = 384 * 1024;
constexpr size_t WS_W_IN = 1 * MiB, WS_W_UQ = 7 * MiB, WS_W_UKV = 8 * MiB + 512 * 1024, WS_W_OUT = 9 * MiB, WS_W_PQ = 11 * MiB;
constexpr size_t WS_PU = 13 * MiB, WS_PV = 29 * MiB;
constexpr size_t WS_SU = 253 * MiB, WS_SV = 253 * MiB + 64 * 1024;
constexpr size_t WS_HB = 77 * MiB;
constexpr size_t WS_CQ = 109 * MiB, WS_CKV = 133 * MiB, WS_KRF = 141 * MiB, WS_KRB = 143 * MiB, WS_MQ = 144 * MiB, WS_MK = 160 * MiB, WS_MV = 176 * MiB;
constexpr size_t WS_QM = 192 * MiB, WS_KN = 216 * MiB, WS_VM = 232 * MiB;
constexpr size_t WS_ROPE = 248 * MiB;
constexpr size_t WS_MOD = 250 * MiB;
constexpr size_t WS_KMEAN = 251 * MiB;
constexpr size_t WS_KH = 252 * MiB, WS_KL = 252 * MiB + 512 * 1024;
constexpr size_t WS_PQ = 109 * MiB;
constexpr size_t WS_EIDX = 173 * MiB, WS_EGATE = 181 * MiB;
constexpr size_t WS_HQ = 189 * MiB;
constexpr size_t WS_HS = 253 * MiB + 128 * 1024;
constexpr size_t WS_PA_HI = 189 * MiB;
constexpr size_t WS_COEF = 205 * MiB, WS_ESU = 229 * MiB, WS_ESV = 237 * MiB;
constexpr size_t WS_Y = 209 * MiB;
constexpr size_t OFF_SSQ_2 = 448 * 1024;
constexpr size_t OFF_KSUM = 512 * 1024;
constexpr int CW_QCTR2 = 8200, CW_CNT = 8448;
constexpr int QR2 = 36;
constexpr int LIST_CAP = 3840;
constexpr size_t WS_LIST = 109 * MiB;
constexpr size_t WS_SELM = 253 * MiB + 256 * 1024;
constexpr size_t WS_QP = 254 * MiB;
constexpr size_t PO_OFF = 0, PML_OFF = 48 * MiB;
constexpr size_t WS_END = 256 * MiB;

constexpr int RING_BYTES = 131072;
constexpr int LDSCTL_OFF = RING_BYTES, MISC_OFF = LDSCTL_OFF + 320;
constexpr int LDS_BYTES = 147456;

#define GAS __attribute__((address_space(1)))
#define LAS __attribute__((address_space(3)))
typedef unsigned short bf16;
typedef unsigned v4u __attribute__((ext_vector_type(4)));
typedef unsigned v2u __attribute__((ext_vector_type(2)));
typedef float f32x4 __attribute__((ext_vector_type(4)));
typedef float f32x2 __attribute__((ext_vector_type(2)));
typedef float f32x16 __attribute__((ext_vector_type(16)));
typedef short bf16x8 __attribute__((ext_vector_type(8)));
typedef short s16x4 __attribute__((ext_vector_type(4)));
typedef __bf16 bf16x2_t __attribute__((ext_vector_type(2)));
typedef GAS unsigned gu32;
#define LDS_WAIT() asm volatile("s_waitcnt lgkmcnt(0)" ::: "memory")
#define VM_WAIT() asm volatile("s_waitcnt vmcnt(0)" ::: "memory")
__device__ __forceinline__ unsigned f2bf(float f) { unsigned u = __builtin_bit_cast(unsigned, f); return (u + 0x7fffu + ((u >> 16) & 1u)) >> 16; }
__device__ __forceinline__ unsigned pk2(float lo, float hi) { f32x2 v = {lo, hi}; bf16x2_t b = __builtin_convertvector(v, bf16x2_t); return __builtin_bit_cast(unsigned, b); }
__device__ __forceinline__ float bflo(unsigned w) { return __builtin_bit_cast(float, w << 16); }
__device__ __forceinline__ float bfhi(unsigned w) { return __builtin_bit_cast(float, w & 0xffff0000u); }
__device__ __forceinline__ float dot2_bf16(unsigned w, unsigned x, float acc) { return __builtin_amdgcn_fdot2_f32_bf16(__builtin_bit_cast(bf16x2_t, w), __builtin_bit_cast(bf16x2_t, x), acc, false); }
__device__ __forceinline__ int opaque_tid() { int t = threadIdx.x; asm volatile("" : "+v"(t)); return t; }
template <int CTRL> __device__ __forceinline__ float dpp_f(float v) { return __builtin_bit_cast(float, __builtin_amdgcn_update_dpp(0, __builtin_bit_cast(int, v), CTRL, 0xf, 0xf, true)); }
__device__ __forceinline__ float lane_xor16(float v) { const auto r = __builtin_amdgcn_permlane16_swap(__builtin_bit_cast(unsigned, v), __builtin_bit_cast(unsigned, v), false, false); return __builtin_bit_cast(float, (threadIdx.x & 16) ? r[0] : r[1]); }
__device__ __forceinline__ float lane_xor32(float v) { const auto r = __builtin_amdgcn_permlane32_swap(__builtin_bit_cast(unsigned, v), __builtin_bit_cast(unsigned, v), false, false); return __builtin_bit_cast(float, (threadIdx.x & 32) ? r[0] : r[1]); }
__device__ __forceinline__ float wave_sum(float v) {
    v += dpp_f<0xB1>(v); v += dpp_f<0x4E>(v); v += dpp_f<0x141>(v); v += dpp_f<0x140>(v);
    v += lane_xor16(v); v += lane_xor32(v);
    return v;
}
__device__ __forceinline__ float wave_max(float v) {
    v = fmaxf(v, dpp_f<0xB1>(v)); v = fmaxf(v, dpp_f<0x4E>(v)); v = fmaxf(v, dpp_f<0x141>(v)); v = fmaxf(v, dpp_f<0x140>(v));
    v = fmaxf(v, lane_xor16(v)); v = fmaxf(v, lane_xor32(v));
    return v;
}

#define XB_TMO      128
#define XB_XCNT(j)  (256  + 64 * (j))
#define XB_XSUB(j)  (1280 + 64 * (j))
#define XB_XGEN(j)  (2304 + 64 * (j))
#define XB_TOP      3328
#define XB_TOPGEN   3392
#define XCD_BAR_WORDS 3456
#define XB_SPIN_CAP (1u << 18)

__device__ __forceinline__ unsigned xb_ld(unsigned* p)              { return __hip_atomic_load(p, __ATOMIC_RELAXED, __HIP_MEMORY_SCOPE_AGENT); }
__device__ __forceinline__ unsigned xb_add(unsigned* p, unsigned v) { return __hip_atomic_fetch_add(p, v, __ATOMIC_RELAXED, __HIP_MEMORY_SCOPE_AGENT); }
__device__ __forceinline__ unsigned xb_xcc_id() { return (unsigned)__builtin_amdgcn_s_getreg((3 << 11) | 20) & 0xFu; }
#define XB_SPIN(cond, bar) do { unsigned _sp = 0; while (cond) { __builtin_amdgcn_s_sleep(1); \
    if ((++_sp & 255u) == 0u) { if (xb_ld(&(bar)[XB_TMO])) break; if (_sp > XB_SPIN_CAP) { atomicAdd(&(bar)[XB_TMO], 1u); break; } } } } while (0)

struct XcdBarrier {
    unsigned* bar; unsigned x;
    volatile LAS unsigned* st;
};

__device__ __forceinline__ XcdBarrier xcd_barrier_post(unsigned* bar, volatile LAS unsigned* st) {
    XcdBarrier b; b.bar = bar; b.x = xb_xcc_id(); b.st = st;
    if (threadIdx.x == 0) st[2] = xb_add(&bar[XB_XCNT(b.x)], 1u);
    return b;
}
__device__ __forceinline__ void xcd_barrier_complete(unsigned* bar, unsigned x, unsigned& nloc, unsigned& nx) {
    const unsigned G = gridDim.x * gridDim.y * gridDim.z;
    unsigned sum, cnt, mine, sp = 0u;
    for (;;) {
        sum = 0u; cnt = 0u; mine = 0u;
#pragma unroll
        for (unsigned j = 0; j < 16; ++j) { const unsigned c = xb_ld(&bar[XB_XCNT(j)]); sum += c; cnt += (c > 0u) ? 1u : 0u; mine = (j == x) ? c : mine; }
        if (sum == G) break;
        __builtin_amdgcn_s_sleep(1);
        if ((++sp & 255u) == 0u) { if (xb_ld(&bar[XB_TMO])) break; if (sp > XB_SPIN_CAP) { atomicAdd(&bar[XB_TMO], 1u); break; } }
    }
    nloc = mine > 0u ? mine : 1u; nx = cnt > 0u ? cnt : 1u;
}

__device__ __forceinline__ void xcd_barrier(const XcdBarrier& b) {
    asm volatile("s_waitcnt vmcnt(0)" ::: "memory");
    __syncthreads();
    if (threadIdx.x == 0) {
        unsigned* bar = b.bar;
        __builtin_amdgcn_s_waitcnt(0);
        unsigned nloc = b.st[0], nx = b.st[1];
        if (nloc == 0u) { xcd_barrier_complete(bar, b.x, nloc, nx); b.st[0] = nloc; b.st[1] = nx; }
        const unsigned old = xb_add(&bar[XB_XSUB(b.x)], 1u);
        const unsigned gen = old / nloc;
        if (old + 1u == (gen + 1u) * nloc) {
            __builtin_amdgcn_fence(__ATOMIC_RELEASE, "agent");
            asm volatile("s_waitcnt vmcnt(0)" ::: "memory");
            const unsigned og = xb_add(&bar[XB_TOP], 1u);
            const unsigned tg = og / nx;
            if (og + 1u == (tg + 1u) * nx) xb_add(&bar[XB_TOPGEN], 1u);
            else XB_SPIN(xb_ld(&bar[XB_TOPGEN]) == tg, bar);
            __builtin_amdgcn_fence(__ATOMIC_ACQUIRE, "agent");
            xb_add(&bar[XB_XGEN(b.x)], 1u);
            asm volatile("s_waitcnt vmcnt(0)" ::: "memory");
        } else {
            XB_SPIN(xb_ld(&bar[XB_XGEN(b.x)]) == gen, bar);
            __builtin_amdgcn_fence(__ATOMIC_ACQUIRE, "agent");
            asm volatile("s_waitcnt vmcnt(0)" ::: "memory");
        }
    }
    __syncthreads();
}


namespace epi {
using pg8::Unit; using pg8::f32x4; using pg8::bf16_t;
__device__ __forceinline__ v4u pack8(const f32x4& a, const f32x4& b, float s) { v4u w; w.x = pk2(a[0] * s, a[1] * s); w.y = pk2(a[2] * s, a[3] * s); w.z = pk2(b[0] * s, b[1] * s); w.w = pk2(b[2] * s, b[3] * s); return w; }
__device__ __forceinline__ float sq8(const f32x4& a, const f32x4& b) { return a[0] * a[0] + a[1] * a[1] + a[2] * a[2] + a[3] * a[3] + b[0] * b[0] + b[1] * b[1] + b[2] * b[2] + b[3] * b[3]; }

struct EpiZ {
    static constexpr bool PERM = true, AFTER_DRAIN = false;
    unsigned char* ws; int dry;
    __device__ __forceinline__ void operator()(const f32x4 (&acc)[2][2][4][2], const Unit& u, int wr, int wc, int fr_in, int fq_in) const {
        bf16_t* const cq = (bf16_t*)(ws + WS_CQ); bf16_t* const ckv = (bf16_t*)(ws + WS_CKV); bf16_t* const mq = (bf16_t*)(ws + WS_MQ); bf16_t* const mk = (bf16_t*)(ws + WS_MK); bf16_t* const mv = (bf16_t*)(ws + WS_MV);
        float* const krf = (float*)(ws + WS_KRF); float* const ssq_q = (float*)(ws + OFF_SSQ_Q); float* const ssq_kv = (float*)(ws + OFF_SSQ_KV);
        int t_ = threadIdx.x; asm volatile("" : "+v"(t_)); const int fr = t_ & 15, fq = (t_ >> 4) & 3;
        const int pn = u.pn;
        if (pn == 10) {
            if (wc == 0) {
#pragma unroll
                for (int ai = 0; ai < 2; ++ai)
#pragma unroll
                    for (int m = 0; m < 4; ++m) { const int row = u.pm * 256 + ai * 128 + wr * 64 + m * 16 + fr; float* p = krf + (size_t)row * 32 + 8 * fq;
                        *(f32x4*)p = acc[ai][0][m][0]; *(f32x4*)(p + 4) = acc[ai][0][m][1]; }
            }
            return;
        }
        bf16_t* base; int ld, cb; float* ssq = nullptr;
        if (pn < 3) { base = cq; ld = 768; cb = pn * 256; ssq = ssq_q; } else if (pn == 3) { base = ckv; ld = 256; cb = 0; ssq = ssq_kv; }
        else if (pn < 6) { base = mq; ld = 512; cb = (pn - 4) * 256; } else if (pn < 8) { base = mk; ld = 512; cb = (pn - 6) * 256; } else { base = mv; ld = 512; cb = (pn - 8) * 256; }
#pragma unroll
        for (int ai = 0; ai < 2; ++ai)
#pragma unroll
            for (int m = 0; m < 4; ++m) { const int row = u.pm * 256 + ai * 128 + wr * 64 + m * 16 + fr; float ss = 0.f;
#pragma unroll
                for (int bj = 0; bj < 2; ++bj) { const int col = cb + bj * 128 + wc * 32 + 8 * fq;
                    *(v4u*)(base + (size_t)row * ld + col) = pack8(acc[ai][bj][m][0], acc[ai][bj][m][1], 1.f); ss += sq8(acc[ai][bj][m][0], acc[ai][bj][m][1]); }
                if (pn <= 3) { ss += lane_xor16(ss); ss += lane_xor32(ss); if (fq == 0 && !dry) atomicAdd(ssq + row, ss); } }
        if (pn == 6 || pn == 7) {
            float* const ksum = (float*)(ws + OFF_KSUM); const int bb = u.pm >> 4, nn = u.pm & 15;
#pragma unroll
            for (int bj = 0; bj < 2; ++bj) { f32x4 s0 = acc[0][bj][0][0], s1 = acc[0][bj][0][1];
#pragma unroll
                for (int ai = 0; ai < 2; ++ai)
#pragma unroll
                    for (int m = 0; m < 4; ++m) if (ai | m) { s0 += acc[ai][bj][m][0]; s1 += acc[ai][bj][m][1]; }
                const int colmk = (pn - 6) * 256 + bj * 128 + wc * 32 + 8 * fq; float* kp = ksum + ((size_t)(bb * 8 + (colmk >> 6)) * 16 + nn) * 64 + (colmk & 63);
#pragma unroll
                for (int j = 0; j < 8; ++j) { float v = (j < 4) ? s0[j & 3] : s1[j & 3]; v += dpp_f<0xB1>(v); v += dpp_f<0x4E>(v); v += dpp_f<0x141>(v); v += dpp_f<0x140>(v); if (fr == 0 && !dry) atomicAdd(kp + j, v); } }
        }
    }
};
struct EpiQ {
    static constexpr bool PERM = true, AFTER_DRAIN = false;
    unsigned char* ws;
    __device__ __forceinline__ void operator()(const f32x4 (&acc)[2][2][4][2], const Unit& u, int wr, int wc, int fr_in, int fq_in) const {
        bf16_t* const qm = (bf16_t*)(ws + WS_QM); const float* const ssq_q = (const float*)(ws + OFF_SSQ_Q);
        int t_ = threadIdx.x; asm volatile("" : "+v"(t_)); const int fr = t_ & 15, fq = (t_ >> 4) & 3;
#pragma unroll
        for (int ai = 0; ai < 2; ++ai)
#pragma unroll
            for (int m = 0; m < 4; ++m) { const int row = u.pm * 256 + ai * 128 + wr * 64 + m * 16 + fr; const float rs = QS_MLA / sqrtf(ssq_q[row] * (1.0f / 768.0f) + EPS);
#pragma unroll
                for (int bj = 0; bj < 2; ++bj) { const int col = u.pn * 256 + bj * 128 + wc * 32 + 8 * fq;
                    *(v4u*)(qm + (size_t)row * 768 + col) = pack8(acc[ai][bj][m][0], acc[ai][bj][m][1], rs); } }
    }
};
struct EpiKV {
    static constexpr bool PERM = true, AFTER_DRAIN = false;
    unsigned char* ws;
    __device__ __forceinline__ void operator()(const f32x4 (&acc)[2][2][4][2], const Unit& u, int wr, int wc, int fr_in, int fq_in) const {
        bf16_t* const kn = (bf16_t*)(ws + WS_KN); bf16_t* const vm = (bf16_t*)(ws + WS_VM); const float* const ssq_kv = (const float*)(ws + OFF_SSQ_KV);
        int t_ = threadIdx.x; asm volatile("" : "+v"(t_)); const int fr = t_ & 15, fq = (t_ >> 4) & 3;
#pragma unroll
        for (int ai = 0; ai < 2; ++ai)
#pragma unroll
            for (int m = 0; m < 4; ++m) { const int row = u.pm * 256 + ai * 128 + wr * 64 + m * 16 + fr; const float rs = 1.0f / sqrtf(ssq_kv[row] * (1.0f / 256.0f) + EPS);
#pragma unroll
                for (int bj = 0; bj < 2; ++bj) { const int col = u.pn * 256 + bj * 128 + wc * 32 + 8 * fq; const int h = col >> 7, w = col & 127;
                    bf16_t* p = (w < 64) ? kn + (size_t)row * 512 + h * 64 + w : vm + (size_t)row * 512 + h * 64 + (w - 64);
                    *(v4u*)p = pack8(acc[ai][bj][m][0], acc[ai][bj][m][1], rs); } }
    }
};
struct EpiRes {
    static constexpr bool PERM = true, AFTER_DRAIN = false;
    unsigned char* ws;
    __device__ __forceinline__ void operator()(const f32x4 (&acc)[2][2][4][2], const Unit& u, int wr, int wc, int fr_in, int fq_in) const {
        const float* const mod = (const float*)(ws + WS_MOD); bf16_t* const y = (bf16_t*)(ws + WS_Y);
        int t_ = threadIdx.x; asm volatile("" : "+v"(t_)); const int fr = t_ & 15, fq = (t_ >> 4) & 3;
        const int b = (u.pm * 256) / S;
        f32x4 gv[2][2];
#pragma unroll
        for (int bj = 0; bj < 2; ++bj) { const f32x4* gp = (const f32x4*)(mod + b * 6 * D + 2 * D + u.pn * 256 + bj * 128 + wc * 32 + 8 * fq); gv[bj][0] = gp[0]; gv[bj][1] = gp[1]; }
#pragma unroll
        for (int ai = 0; ai < 2; ++ai)
#pragma unroll
            for (int m = 0; m < 4; ++m) { const int row = u.pm * 256 + ai * 128 + wr * 64 + m * 16 + fr;
#pragma unroll
                for (int bj = 0; bj < 2; ++bj) { const int col = u.pn * 256 + bj * 128 + wc * 32 + 8 * fq;
                    *(v4u*)(y + (size_t)row * D + col) = pack8(gv[bj][0] * acc[ai][bj][m][0], gv[bj][1] * acc[ai][bj][m][1], 1.f); } }
    }
};
struct EpiF32 {
    static constexpr bool PERM = true, AFTER_DRAIN = false;
    float* o; int ld;
    __device__ __forceinline__ void operator()(const f32x4 (&acc)[2][2][4][2], const Unit& u, int wr, int wc, int fr_in, int fq_in) const {
        int t_ = threadIdx.x; asm volatile("" : "+v"(t_)); const int fr = t_ & 15, fq = (t_ >> 4) & 3;
#pragma unroll
        for (int ai = 0; ai < 2; ++ai)
#pragma unroll
            for (int m = 0; m < 4; ++m) { const int row = u.pm * 256 + ai * 128 + wr * 64 + m * 16 + fr;
#pragma unroll
                for (int bj = 0; bj < 2; ++bj) { const int col = u.pn * 256 + bj * 128 + wc * 32 + 8 * fq; f32x4* op = (f32x4*)(o + (size_t)row * ld + col); op[0] = acc[ai][bj][m][0]; op[1] = acc[ai][bj][m][1]; } }
    }
};
}

namespace att {
__device__ __forceinline__ int crow(int r, int hi) { return (r & 3) + 8 * (r >> 2) + 4 * hi; }
constexpr int VP = 192;
constexpr int BIAS_OFF = 2 * (64 * 208 + 64 * VP);
constexpr int BT_GUARD = 96;
constexpr int UNI_OFF = BIAS_OFF + 4608;
__device__ __forceinline__ int t5_bucket(int d) {
    if (d < 16) return d;
    int b = 16;
    b += (d >= 21); b += (d >= 27); b += (d >= 35); b += (d >= 46); b += (d >= 59); b += (d >= 77); b += (d >= 99); b += (d >= 128);
    b += (d >= 166); b += (d >= 216); b += (d >= 280); b += (d >= 363); b += (d >= 470); b += (d >= 609); b += (d >= 790);
    return b;
}
struct MergeCtx { const unsigned* selm; const unsigned short* qp; const bf16* po; const float* pml; const LAS unsigned* pbase; int fill_table; };
template <bool MOBA>
__device__ __forceinline__ void softmax_pv(f32x16& p0, f32x16& p1, f32x16& o0, f32x16& o1, f32x16& negm, float& mrun, float& lrun, const LAS unsigned char* vb, int lane, int hi) {
                float mxa = __builtin_fmaxf(__builtin_fmaxf(p0[0], p0[1]), p1[0]), mxb = __builtin_fmaxf(__builtin_fmaxf(p0[2], p0[3]), p1[1]);
                mxa = __builtin_fmaxf(__builtin_fmaxf(mxa, p1[2]), p1[3]);
#pragma unroll
                for (int r = 4; r < 16; r += 4) { mxa = __builtin_fmaxf(__builtin_fmaxf(mxa, p0[r]), p0[r + 1]); mxb = __builtin_fmaxf(__builtin_fmaxf(mxb, p0[r + 2]), p0[r + 3]);
                    mxa = __builtin_fmaxf(__builtin_fmaxf(mxa, p1[r]), p1[r + 1]); mxb = __builtin_fmaxf(__builtin_fmaxf(mxb, p1[r + 2]), p1[r + 3]); }
                float mx = __builtin_fmaxf(mxa, mxb);
                mx = fmaxf(mx, lane_xor32(mx));
                if (__any(mx > 8.f)) {
                    const float dl = fmaxf(mx, 0.f); const float alpha = __builtin_amdgcn_exp2f(-dl); mrun += dl; lrun *= alpha;
                    const float nm = (!MOBA) ? -mrun : -mrun * (1.0f / QS_MOBA);
#pragma unroll
                    for (int r = 0; r < 16; ++r) { o0[r] *= alpha; o1[r] *= alpha; p0[r] -= dl; p1[r] -= dl; negm[r] = nm; }
                }
                float ls = 0.f;
#pragma unroll
                for (int r = 0; r < 16; ++r) { p0[r] = __builtin_amdgcn_exp2f(p0[r]); p1[r] = __builtin_amdgcn_exp2f(p1[r]); ls += p0[r] + p1[r]; }
                lrun += ls;
                v4u pw[4];
#pragma unroll
                for (int s = 0; s < 4; ++s) {
                    const f32x16& P = (s < 2) ? p0 : p1; const int rb = 8 * (s & 1);
                    pw[s].x = pk2(P[rb + 0], P[rb + 1]); pw[s].y = pk2(P[rb + 2], P[rb + 3]); pw[s].z = pk2(P[rb + 4], P[rb + 5]); pw[s].w = pk2(P[rb + 6], P[rb + 7]);
                }
                const int vlane = ((lane & 15) >> 2) * VP + (((lane >> 4) & 1) * 16 + 4 * (lane & 3)) * 2;
#pragma unroll
                for (int s = 0; s < 4; ++s) {
                    const int kbs = (s >> 1) * 32 + 16 * (s & 1) + 4 * hi;
#pragma unroll
                    for (int d0 = 0; d0 < 2; ++d0) {
                        const LAS unsigned char* vp = vb + kbs * VP + vlane + d0 * 64;
                        const s16x4 lo = __builtin_bit_cast(s16x4, __builtin_amdgcn_ds_read_tr16_b64_v4i16((LAS s16x4*)(vp)));
                        const s16x4 hh = __builtin_bit_cast(s16x4, __builtin_amdgcn_ds_read_tr16_b64_v4i16((LAS s16x4*)(vp + 8 * VP)));
                        const bf16x8 vf = (bf16x8){lo[0], lo[1], lo[2], lo[3], hh[0], hh[1], hh[2], hh[3]};
                        if (d0 == 0) o0 = __builtin_amdgcn_mfma_f32_32x32x16_bf16(vf, __builtin_bit_cast(bf16x8, pw[s]), o0, 0, 0, 0);
                        else o1 = __builtin_amdgcn_mfma_f32_32x32x16_bf16(vf, __builtin_bit_cast(bf16x8, pw[s]), o1, 0, 0, 0);
                    }
                }
}
template <int MODE>
__device__ __forceinline__ void attn_unit(LAS unsigned char* lds, int b, int h, int qb, const bf16* __restrict__ Q, const bf16* __restrict__ K1, const bf16* __restrict__ K2,
                                          const bf16* __restrict__ V, const float* __restrict__ kmean, const float* __restrict__ rel_bias, bf16* __restrict__ O, int ocol0, const MergeCtx* mc = nullptr) {
    constexpr int DQ = MODE == 0 ? 96 : 64, KP = MODE == 0 ? 208 : 144, NKS = DQ / 16, KTB = 64 * KP, STAGE = KTB + 64 * VP;
    const int tid = opaque_tid(), lane = tid & 63, r32 = lane & 31, hi = lane >> 5; const int wid = __builtin_amdgcn_readfirstlane(tid >> 6);
    const size_t rowbase = (size_t)b * S; const int q0 = qb * 256; const int qin = wid * 32 + r32;
    const size_t tq = rowbase + q0 + qin;
    bf16x8 qr[NKS];
    { const bf16* qp = (MODE == 0) ? Q + tq * 768 + h * 96 : Q + tq * 512 + h * 64;
#pragma unroll
      for (int d0 = 0; d0 < NKS; ++d0) qr[d0] = *(const bf16x8*)(qp + d0 * 16 + hi * 8); }
    if (MODE == 0) {
        const f32x4* cs = (const f32x4*)(kmean + (tq * 16 + 8 * hi) * 2);
        bf16x8 a = qr[NKS - 2], c = qr[NKS - 1];
#pragma unroll
        for (int jj = 0; jj < 4; ++jj) { const f32x4 t4 = cs[jj];
#pragma unroll
            for (int e = 0; e < 2; ++e) { const int j = 2 * jj + e; const float x1 = bflo((unsigned)(unsigned short)a[j]), x2 = bflo((unsigned)(unsigned short)c[j]); const float co = t4[2 * e], si = t4[2 * e + 1];
                a[j] = (short)f2bf(x1 * co - x2 * si); c[j] = (short)f2bf(x2 * co + x1 * si); } }
        qr[NKS - 2] = a; qr[NKS - 1] = c;
    }
    unsigned selmask = 0xffffu, uni = 0xffffu;
    if (MODE == 1) {
        LAS float* bt = (LAS float*)(lds + BIAS_OFF);
        for (int i = tid; i < BT_GUARD + 1024; i += 512) bt[i] = (i < BT_GUARD) ? -1e30f : rel_bias[t5_bucket(i - BT_GUARD) * 8 + h] * LOG2E;
        if (qb > 3) {
            float g[16];
#pragma unroll
            for (int n = 0; n < 16; ++n) { float a = 0.f;
                if (n < qb) { const float* km = kmean + ((size_t)(b * 8 + h) * 16 + n) * 64 + hi * 8;
#pragma unroll
                    for (int d0 = 0; d0 < 4; ++d0) { const f32x4 k0 = *(const f32x4*)(km + d0 * 16), k1 = *(const f32x4*)(km + d0 * 16 + 4); const bf16x8 qq = qr[d0];
                        a += bflo((unsigned)(unsigned short)qq[0]) * k0[0] + bflo((unsigned)(unsigned short)qq[1]) * k0[1] + bflo((unsigned)(unsigned short)qq[2]) * k0[2] + bflo((unsigned)(unsigned short)qq[3]) * k0[3]
                           + bflo((unsigned)(unsigned short)qq[4]) * k1[0] + bflo((unsigned)(unsigned short)qq[5]) * k1[1] + bflo((unsigned)(unsigned short)qq[6]) * k1[2] + bflo((unsigned)(unsigned short)qq[7]) * k1[3]; }
                    a += lane_xor32(a); }
                g[n] = a; }
            unsigned mk = 0;
#pragma unroll
            for (int r = 0; r < 3; ++r) { int bi = 0; float bv = -INFINITY;
#pragma unroll
                for (int n = 0; n < 16; ++n) if (n < qb && !((mk >> n) & 1u) && g[n] > bv) { bv = g[n]; bi = n; }
                mk |= 1u << bi; }
            selmask = mk;
        } else selmask = (1u << qb) - 1u;
        __syncthreads();
        { unsigned um = selmask;
#pragma unroll
          for (int o = 1; o < 64; o <<= 1) um |= __shfl_xor(um, o);
          if (lane == 0) ((LAS unsigned*)(lds + UNI_OFF))[wid] = um; }
        __syncthreads();
        uni = 0u;
#pragma unroll
        for (int w = 0; w < 8; ++w) uni |= ((const LAS unsigned*)(lds + UNI_OFF))[w];
    }
    if (MODE == 2) {
        if (mc->fill_table) { LAS float* bt = (LAS float*)(lds + BIAS_OFF);
            for (int i = tid; i < BT_GUARD + 1024; i += 512) bt[i] = (i < BT_GUARD) ? -1e30f : rel_bias[t5_bucket(i - BT_GUARD) * 8 + h] * LOG2E; }
        uni = 0u; selmask = 0u;
        __syncthreads();
    }
    float mk_[3] = {-1e30f, -1e30f, -1e30f}, lk_[3] = {0.f, 0.f, 0.f}; unsigned pi_[3] = {0u, 0u, 0u}; int ns = 0;
    if (MODE == 2) { unsigned mm = mc->selm[tq * 8 + h]; const int bh = b * 8 + h; const v2u qpw = *(const v2u*)(mc->qp + (tq * 8 + h) * 4);
        const unsigned qps[3] = {qpw.x & 0xffffu, qpw.x >> 16, qpw.y & 0xffffu};
#pragma unroll
        for (int k = 0; k < 3; ++k) { if (mm) { const int n = __builtin_ctz(mm); mm &= mm - 1u; const unsigned pidx = mc->pbase[bh * 15 + n] + qps[k];
                pi_[k] = pidx; mk_[k] = mc->pml[(size_t)pidx * 2]; lk_[k] = mc->pml[(size_t)pidx * 2 + 1]; ns = k + 1; } } }

    float mrun = 0.f, lrun = 0.f;
    f32x16 o0 = {}, o1 = {}, negm = {};
    const int NT = 4 * (qb + 1);
    v4u kreg0, kreg1 = {}, vreg;
    const bf16* Kh = K1 + rowbase * 512 + h * 64; const bf16* Vh = V + rowbase * 512 + h * 64; const bf16* Krh = (MODE == 0) ? K2 + rowbase * 32 : nullptr;
#define LOAD_TILE(KT) do { const int k0_ = (KT) * 64; \
        if (MODE == 0) { \
            { const int p_ = tid, key_ = p_ / 12, c_ = p_ % 12; kreg0 = (c_ < 8) ? *(const v4u*)(Kh + (size_t)(k0_ + key_) * 512 + c_ * 8) : *(const v4u*)(Krh + (size_t)(k0_ + key_) * 32 + (c_ - 8) * 8); } \
            if (tid < 256) { const int p_ = 512 + tid, key_ = p_ / 12, c_ = p_ % 12; kreg1 = (c_ < 8) ? *(const v4u*)(Kh + (size_t)(k0_ + key_) * 512 + c_ * 8) : *(const v4u*)(Krh + (size_t)(k0_ + key_) * 32 + (c_ - 8) * 8); } \
        } else { const int key_ = tid >> 3, c_ = tid & 7; kreg0 = *(const v4u*)(Kh + (size_t)(k0_ + key_) * 512 + c_ * 8); } \
        { const int key_ = tid >> 3, c_ = tid & 7; vreg = *(const v4u*)(Vh + (size_t)(k0_ + key_) * 512 + c_ * 8); } } while (0)
#define STORE_TILE(ST) do { LAS unsigned char* kb_ = lds + (ST) * STAGE; LAS unsigned char* vb_ = kb_ + KTB; \
        if (MODE == 0) { \
            { const int p_ = tid, key_ = p_ / 12, c_ = p_ % 12; *(LAS v4u*)(kb_ + key_ * KP + c_ * 16) = kreg0; } \
            if (tid < 256) { const int p_ = 512 + tid, key_ = p_ / 12, c_ = p_ % 12; *(LAS v4u*)(kb_ + key_ * KP + c_ * 16) = kreg1; } \
        } else { const int key_ = tid >> 3, c_ = tid & 7; *(LAS v4u*)(kb_ + key_ * KP + c_ * 16) = kreg0; } \
        { const int key_ = tid >> 3, c_ = tid & 7; *(LAS v4u*)(vb_ + key_ * VP + c_ * 16) = vreg; } } while (0)
    int kt = 0;
    if (MODE != 0) { while (kt < 4 * qb && !((uni >> (kt >> 2)) & 1u)) kt += 4; }
    LOAD_TILE(kt); STORE_TILE(0);
    __syncthreads();
    int st = 0;
    while (kt < NT) {
        int ktn = kt + 1;
        if (MODE != 0) { while (ktn < 4 * qb && !((uni >> (ktn >> 2)) & 1u)) ktn += 4; }
        if (ktn < NT) LOAD_TILE(ktn);
        {
            const LAS unsigned char* kb = lds + st * STAGE; const LAS unsigned char* vb = kb + KTB;
            const int nblk = kt >> 2; const bool past = (MODE == 1) && (nblk < qb);
            bool active = true;
            if (past) active = __any((int)((selmask >> nblk) & 1u)) != 0;
            if (kt >= 4 * qb && (kt - 4 * qb) * 64 > wid * 32 + 31) active = false;
            if (active) {
                f32x16 p0, p1;
#pragma unroll
                for (int d0 = 0; d0 < NKS; ++d0) {
                    const bf16x8 a0 = *(const LAS bf16x8*)(kb + r32 * KP + (16 * d0 + 8 * hi) * 2);
                    const bf16x8 a1 = *(const LAS bf16x8*)(kb + (32 + r32) * KP + (16 * d0 + 8 * hi) * 2);
                    if (d0 == 0) { p0 = __builtin_amdgcn_mfma_f32_32x32x16_bf16(a0, qr[0], negm, 0, 0, 0); p1 = __builtin_amdgcn_mfma_f32_32x32x16_bf16(a1, qr[0], negm, 0, 0, 0); }
                    else { p0 = __builtin_amdgcn_mfma_f32_32x32x16_bf16(a0, qr[d0], p0, 0, 0, 0); p1 = __builtin_amdgcn_mfma_f32_32x32x16_bf16(a1, qr[d0], p1, 0, 0, 0); }
                }
                if (MODE == 0) {
                    if (kt >= 4 * qb) { const int kb0 = (kt - 4 * qb) * 64; asm volatile("" ::: "memory");
#pragma unroll
                        for (int r = 0; r < 16; ++r) { const int kk = kb0 + crow(r, hi); if (kk > qin) p0[r] = -1e30f; if (kk + 32 > qin) p1[r] = -1e30f; } }
                } else {
                    const LAS float* bt = (const LAS float*)(lds + BIAS_OFF);
                    const bool seld = !past || ((selmask >> nblk) & 1u);
                    const int dmin = (qb - nblk) * 256 + wid * 32 - (kt & 3) * 64 - 63;
                    if (dmin >= 790) { const float c31 = seld ? bt[BT_GUARD + 1023] : -1e30f;
#pragma unroll
                        for (int r = 0; r < 16; ++r) { p0[r] = p0[r] * QS_MOBA + c31; p1[r] = p1[r] * QS_MOBA + c31; } }
                    else {
                        const int D0 = (qb - nblk) * 256 + qin - (kt & 3) * 64 - 4 * hi;
                        const int bidx = seld ? (D0 + BT_GUARD - 59) : 0;
                        const LAS float* bp = bt + bidx;
#pragma unroll
                        for (int r = 0; r < 16; ++r) { const int kr = (r & 3) + 8 * (r >> 2);
                            p0[r] = p0[r] * QS_MOBA + bp[59 - kr]; p1[r] = p1[r] * QS_MOBA + bp[59 - kr - 32]; } }
                }
                softmax_pv<MODE != 0>(p0, p1, o0, o1, negm, mrun, lrun, vb, lane, hi);
            }
        }
        if (ktn < NT) STORE_TILE(st ^ 1);
        __syncthreads();
        st ^= 1; kt = ktn;
    }
    const float lt = lrun + lane_xor32(lrun); float il = 1.0f / fmaxf(lt, 1e-30f);
    if (MODE == 2) {
        float M = mrun;
#pragma unroll
        for (int k = 0; k < 3; ++k) M = fmaxf(M, mk_[k]);
        const float w0 = __builtin_amdgcn_exp2f(mrun - M);
        float den = lt * w0;
#pragma unroll
        for (int r = 0; r < 16; ++r) { o0[r] *= w0; o1[r] *= w0; }
#pragma unroll
        for (int k = 0; k < 3; ++k) { if (k < ns) { const float wk = lk_[k] * __builtin_amdgcn_exp2f(mk_[k] - M); den += wk; const bf16* pp = mc->po + (size_t)pi_[k] * 64 + 4 * hi;
#pragma unroll
                for (int g4 = 0; g4 < 4; ++g4) { const v2u a = *(const v2u*)(pp + 8 * g4), c = *(const v2u*)(pp + 32 + 8 * g4);
                    o0[4 * g4] += wk * bflo(a.x); o0[4 * g4 + 1] += wk * bfhi(a.x); o0[4 * g4 + 2] += wk * bflo(a.y); o0[4 * g4 + 3] += wk * bfhi(a.y);
                    o1[4 * g4] += wk * bflo(c.x); o1[4 * g4 + 1] += wk * bfhi(c.x); o1[4 * g4 + 2] += wk * bflo(c.y); o1[4 * g4 + 3] += wk * bfhi(c.y); } } }
        il = 1.0f / fmaxf(den, 1e-30f);
    }
    bf16* op = O + tq * 1024 + ocol0 + h * 64;
#pragma unroll
    for (int g4 = 0; g4 < 4; ++g4) {
        v2u w0, w1;
        w0.x = pk2(o0[4 * g4 + 0] * il, o0[4 * g4 + 1] * il); w0.y = pk2(o0[4 * g4 + 2] * il, o0[4 * g4 + 3] * il);
        w1.x = pk2(o1[4 * g4 + 0] * il, o1[4 * g4 + 1] * il); w1.y = pk2(o1[4 * g4 + 2] * il, o1[4 * g4 + 3] * il);
        *(v2u*)(op + 8 * g4 + 4 * hi) = w0; *(v2u*)(op + 32 + 8 * g4 + 4 * hi) = w1;
    }
    __syncthreads();
#undef LOAD_TILE
#undef STORE_TILE
}

__device__ __forceinline__ void moba_past_sub(LAS unsigned char* lds, int b, int h, int n, int sub, unsigned cnt, unsigned pbase, const unsigned short* __restrict__ list, const bf16* __restrict__ MQp,
                                              const bf16* __restrict__ MKp, const bf16* __restrict__ MVp, const float* __restrict__ rel_bias, bf16* __restrict__ po, float* __restrict__ pml, bool fill_table) {
    constexpr int KP = 144, KTB = 64 * KP, VTB = 64 * VP, VOFF = 4 * KTB, BT_OFF = VOFF + 4 * VTB;
    const int tid = opaque_tid(), lane = tid & 63, r32 = lane & 31, hi = lane >> 5; const int wid = __builtin_amdgcn_readfirstlane(tid >> 6);
    const size_t rowbase = (size_t)b * S;
    { const bf16* Kh = MKp + (rowbase + (size_t)n * 256) * 512 + h * 64; const bf16* Vh = MVp + (rowbase + (size_t)n * 256) * 512 + h * 64;
#pragma unroll
      for (int i = 0; i < 4; ++i) { const int p = tid + 512 * i, key = p >> 3, c = p & 7;
          const v4u kv = *(const v4u*)(Kh + (size_t)key * 512 + c * 8), vv = *(const v4u*)(Vh + (size_t)key * 512 + c * 8);
          *(LAS v4u*)(lds + key * KP + c * 16) = kv; *(LAS v4u*)(lds + VOFF + key * VP + c * 16) = vv; }
      if (fill_table) { LAS float* bt = (LAS float*)(lds + BT_OFF);
          for (int i = tid; i < BT_GUARD + 1024; i += 512) bt[i] = (i < BT_GUARD) ? -1e30f : rel_bias[t5_bucket(i - BT_GUARD) * 8 + h] * LOG2E; } }
    __syncthreads();
#pragma unroll 1
    for (int c2 = 0; c2 < 2; ++c2) {
    const unsigned chunk = (unsigned)(sub * 16 + c2 * 8 + wid);
    if (chunk * 32u < cnt) {
        const unsigned e = chunk * 32u + (unsigned)r32; const bool valid = e < cnt; const unsigned ent = list[valid ? e : chunk * 32u];
        const int qpos = (int)(ent & 4095u);
        bf16x8 qr[4];
        { const bf16* qp = MQp + (rowbase + (size_t)qpos) * 512 + h * 64;
#pragma unroll
          for (int d0 = 0; d0 < 4; ++d0) qr[d0] = *(const bf16x8*)(qp + d0 * 16 + hi * 8); }
        float mrun = 0.f, lrun = 0.f; f32x16 o0 = {}, o1 = {}, negm = {};
        const LAS float* bt = (const LAS float*)(lds + BT_OFF);
#pragma unroll 1
        for (int kt = 0; kt < 4; ++kt) {
            const LAS unsigned char* kb = lds + kt * KTB; const LAS unsigned char* vb = lds + VOFF + kt * VTB;
            f32x16 p0, p1;
#pragma unroll
            for (int d0 = 0; d0 < 4; ++d0) {
                const bf16x8 a0 = *(const LAS bf16x8*)(kb + r32 * KP + (16 * d0 + 8 * hi) * 2), a1 = *(const LAS bf16x8*)(kb + (32 + r32) * KP + (16 * d0 + 8 * hi) * 2);
                if (d0 == 0) { p0 = __builtin_amdgcn_mfma_f32_32x32x16_bf16(a0, qr[0], negm, 0, 0, 0); p1 = __builtin_amdgcn_mfma_f32_32x32x16_bf16(a1, qr[0], negm, 0, 0, 0); }
                else { p0 = __builtin_amdgcn_mfma_f32_32x32x16_bf16(a0, qr[d0], p0, 0, 0, 0); p1 = __builtin_amdgcn_mfma_f32_32x32x16_bf16(a1, qr[d0], p1, 0, 0, 0); }
            }
            const int D0 = qpos - (n * 256 + kt * 64) - 4 * hi;
            if (__all(D0 - 59 >= 790)) { const float c31 = bt[BT_GUARD + 1023];
#pragma unroll
                for (int r = 0; r < 16; ++r) { p0[r] = p0[r] * QS_MOBA + c31; p1[r] = p1[r] * QS_MOBA + c31; } }
            else { const int bidx = min(D0, 1023) + BT_GUARD - 59; const LAS float* bp = bt + bidx;
#pragma unroll
                for (int r = 0; r < 16; ++r) { const int kr = (r & 3) + 8 * (r >> 2); p0[r] = p0[r] * QS_MOBA + bp[59 - kr]; p1[r] = p1[r] * QS_MOBA + bp[59 - kr - 32]; } }
            softmax_pv<true>(p0, p1, o0, o1, negm, mrun, lrun, vb, lane, hi);
        }
        const float lt = lrun + lane_xor32(lrun); const float il = 1.0f / fmaxf(lt, 1e-30f);
        if (valid) {
            const size_t pidx = (size_t)pbase + e; bf16* op = po + pidx * 64 + 4 * hi;
#pragma unroll
            for (int g4 = 0; g4 < 4; ++g4) { v2u w0, w1;
                w0.x = pk2(o0[4 * g4 + 0] * il, o0[4 * g4 + 1] * il); w0.y = pk2(o0[4 * g4 + 2] * il, o0[4 * g4 + 3] * il);
                w1.x = pk2(o1[4 * g4 + 0] * il, o1[4 * g4 + 1] * il); w1.y = pk2(o1[4 * g4 + 2] * il, o1[4 * g4 + 3] * il);
                *(v2u*)(op + 8 * g4) = w0; *(v2u*)(op + 32 + 8 * g4) = w1; }
            if (hi == 0) { pml[pidx * 2] = mrun; pml[pidx * 2 + 1] = lt; }
        }
    }
    }
    __syncthreads();
}

__device__ __forceinline__ void moba_own_unit(LAS unsigned char* lds, int b, int h, int qb, const bf16* __restrict__ MQp, const bf16* __restrict__ MKp, const bf16* __restrict__ MVp,
                                              const float* __restrict__ rel_bias, bf16* __restrict__ O, int ocol0, const MergeCtx* mc) {
    constexpr int KP = 144, KTB = 64 * KP, VTB = 64 * VP, VOFF = 4 * KTB, BT_OFF = VOFF + 4 * VTB;
    const int tid = opaque_tid(), lane = tid & 63, r32 = lane & 31, hi = lane >> 5; const int wid = __builtin_amdgcn_readfirstlane(tid >> 6);
    const size_t rowbase = (size_t)b * S; const int qin = wid * 32 + r32; const size_t tq = rowbase + (size_t)qb * 256 + qin;
    { const bf16* Kh = MKp + (rowbase + (size_t)qb * 256) * 512 + h * 64; const bf16* Vh = MVp + (rowbase + (size_t)qb * 256) * 512 + h * 64;
#pragma unroll
      for (int i = 0; i < 4; ++i) { const int p = tid + 512 * i, key = p >> 3, c = p & 7;
          const v4u kv = *(const v4u*)(Kh + (size_t)key * 512 + c * 8), vv = *(const v4u*)(Vh + (size_t)key * 512 + c * 8);
          *(LAS v4u*)(lds + key * KP + c * 16) = kv; *(LAS v4u*)(lds + VOFF + key * VP + c * 16) = vv; }
      if (mc->fill_table) { LAS float* bt = (LAS float*)(lds + BT_OFF);
          for (int i = tid; i < BT_GUARD + 1024; i += 512) bt[i] = (i < BT_GUARD) ? -1e30f : rel_bias[t5_bucket(i - BT_GUARD) * 8 + h] * LOG2E; } }
    bf16x8 qr[4];
    { const bf16* qp = MQp + tq * 512 + h * 64;
#pragma unroll
      for (int d0 = 0; d0 < 4; ++d0) qr[d0] = *(const bf16x8*)(qp + d0 * 16 + hi * 8); }
    float mk_[3] = {-1e30f, -1e30f, -1e30f}, lk_[3] = {0.f, 0.f, 0.f}; unsigned pi_[3] = {0u, 0u, 0u}; int ns = 0;
    { unsigned mm = mc->selm[tq * 8 + h]; const int bh = b * 8 + h; const v2u qpw = *(const v2u*)(mc->qp + (tq * 8 + h) * 4);
      const unsigned qps[3] = {qpw.x & 0xffffu, qpw.x >> 16, qpw.y & 0xffffu};
#pragma unroll
      for (int k = 0; k < 3; ++k) { if (mm) { const int n = __builtin_ctz(mm); mm &= mm - 1u; const unsigned pidx = mc->pbase[bh * 15 + n] + qps[k];
              pi_[k] = pidx; mk_[k] = mc->pml[(size_t)pidx * 2]; lk_[k] = mc->pml[(size_t)pidx * 2 + 1]; ns = k + 1; } } }
    __syncthreads();
    float mrun = 0.f, lrun = 0.f; f32x16 o0 = {}, o1 = {}, negm = {};
    const LAS float* bt = (const LAS float*)(lds + BT_OFF);
    const int ntile = ((wid * 32 + 31) >> 6) + 1;
#pragma unroll 1
    for (int kt = 0; kt < ntile; ++kt) {
        const LAS unsigned char* kb = lds + kt * KTB; const LAS unsigned char* vb = lds + VOFF + kt * VTB;
        f32x16 p0, p1;
#pragma unroll
        for (int d0 = 0; d0 < 4; ++d0) {
            const bf16x8 a0 = *(const LAS bf16x8*)(kb + r32 * KP + (16 * d0 + 8 * hi) * 2), a1 = *(const LAS bf16x8*)(kb + (32 + r32) * KP + (16 * d0 + 8 * hi) * 2);
            if (d0 == 0) { p0 = __builtin_amdgcn_mfma_f32_32x32x16_bf16(a0, qr[0], negm, 0, 0, 0); p1 = __builtin_amdgcn_mfma_f32_32x32x16_bf16(a1, qr[0], negm, 0, 0, 0); }
            else { p0 = __builtin_amdgcn_mfma_f32_32x32x16_bf16(a0, qr[d0], p0, 0, 0, 0); p1 = __builtin_amdgcn_mfma_f32_32x32x16_bf16(a1, qr[d0], p1, 0, 0, 0); }
        }
        const int D0 = qin - kt * 64 - 4 * hi;
        const LAS float* bp = bt + (D0 + BT_GUARD - 59);
#pragma unroll
        for (int r = 0; r < 16; ++r) { const int kr = (r & 3) + 8 * (r >> 2); p0[r] = p0[r] * QS_MOBA + bp[59 - kr]; p1[r] = p1[r] * QS_MOBA + bp[59 - kr - 32]; }
        softmax_pv<true>(p0, p1, o0, o1, negm, mrun, lrun, vb, lane, hi);
    }
    const float lt = lrun + lane_xor32(lrun);
    float M = mrun;
#pragma unroll
    for (int k = 0; k < 3; ++k) M = fmaxf(M, mk_[k]);
    const float w0 = __builtin_amdgcn_exp2f(mrun - M); float den = lt * w0;
#pragma unroll
    for (int r = 0; r < 16; ++r) { o0[r] *= w0; o1[r] *= w0; }
#pragma unroll
    for (int k = 0; k < 3; ++k) { if (k < ns) { const float wk = lk_[k] * __builtin_amdgcn_exp2f(mk_[k] - M); den += wk; const bf16* pp = mc->po + (size_t)pi_[k] * 64 + 4 * hi;
#pragma unroll
            for (int g4 = 0; g4 < 4; ++g4) { const v2u a = *(const v2u*)(pp + 8 * g4), c = *(const v2u*)(pp + 32 + 8 * g4);
                o0[4 * g4] += wk * bflo(a.x); o0[4 * g4 + 1] += wk * bfhi(a.x); o0[4 * g4 + 2] += wk * bflo(a.y); o0[4 * g4 + 3] += wk * bfhi(a.y);
                o1[4 * g4] += wk * bflo(c.x); o1[4 * g4 + 1] += wk * bfhi(c.x); o1[4 * g4 + 2] += wk * bflo(c.y); o1[4 * g4 + 3] += wk * bfhi(c.y); } } }
    const float il = 1.0f / fmaxf(den, 1e-30f);
    bf16* op = O + tq * 1024 + ocol0 + h * 64;
#pragma unroll
    for (int g4 = 0; g4 < 4; ++g4) { v2u w0_, w1_;
        w0_.x = pk2(o0[4 * g4 + 0] * il, o0[4 * g4 + 1] * il); w0_.y = pk2(o0[4 * g4 + 2] * il, o0[4 * g4 + 3] * il);
        w1_.x = pk2(o1[4 * g4 + 0] * il, o1[4 * g4 + 1] * il); w1_.y = pk2(o1[4 * g4 + 2] * il, o1[4 * g4 + 3] * il);
        *(v2u*)(op + 8 * g4 + 4 * hi) = w0_; *(v2u*)(op + 32 + 8 * g4 + 4 * hi) = w1_; }
    __syncthreads();
}
}


namespace srt {
__device__ __forceinline__ void ce(float& a, float& b) { const float hi = fmaxf(a, b), lo = fminf(a, b); a = hi; b = lo; }
template <int N> __device__ __forceinline__ void sort_desc(float (&a)[N]) {
    static_assert(N == 16, "sort_desc: N = 16");
#pragma unroll
    for (int kk = 1; kk <= 4; ++kk)
#pragma unroll
        for (int jj = 3; jj >= 0; --jj) { if (jj < kk) { const int k = 1 << kk, j = 1 << jj;
#pragma unroll
            for (int i = 0; i < 16; ++i) { const int l = i ^ j; if (l > i) { if ((i & k) == 0) ce(a[i], a[l]); else ce(a[l], a[i]); } } } }
}
__device__ __forceinline__ void merge16(float (&a)[16], const float (&b)[16]) {
#pragma unroll
    for (int i = 0; i < 16; ++i) a[i] = fmaxf(a[i], b[15 - i]);
#pragma unroll
    for (int jj = 3; jj >= 0; --jj) { const int j = 1 << jj;
#pragma unroll
        for (int i = 0; i < 16; ++i) { const int l = i ^ j; if (l > i) ce(a[i], a[l]); } }
}
__device__ __forceinline__ void merge_partner(float (&a)[16], bool upper) {
    float b[16];
#pragma unroll
    for (int i = 0; i < 16; ++i) b[i] = __shfl_xor(a[i], 32);
    merge16(a, b);
}
struct Pairs { int a[50], b[50]; };
__host__ __device__ constexpr Pairs make_pairs() { Pairs p{}; int n = 0; for (int k0 = 0; k0 < 16; ++k0) for (int k1 = 0; k1 < 16; ++k1) if ((k0 + 1) * (k1 + 1) <= 16) { p.a[n] = k0; p.b[n] = k1; ++n; } return p; }
template <int I> __device__ __forceinline__ void cand_fill(const float (&s0)[16], const float (&s1)[16], int hi, float (&c0)[16], float (&c1)[16]) {
    float v = -INFINITY;
    if constexpr (I < 25) { constexpr Pairs P = make_pairs(); constexpr int a0 = P.a[I], b0 = P.b[I], a1 = P.a[25 + I], b1 = P.b[25 + I];
        const float va = s0[a0] + s1[b0], vb = s0[a1] + s1[b1]; const float x = hi ? vb : va; const unsigned cc = hi ? (unsigned)(a1 * 16 + b1) : (unsigned)(a0 * 16 + b0);
        v = __builtin_bit_cast(float, (__builtin_bit_cast(unsigned, x) & ~255u) | cc); }
    if constexpr (I < 16) c0[I] = v; else c1[I - 16] = v;
    if constexpr (I + 1 < 32) cand_fill<I + 1>(s0, s1, hi, c0, c1);
}
}


namespace peer {
struct Idx { v4u a, b, c, d; };
__device__ __forceinline__ Idx load_idx(const int* eidx, int t, int g) { const v4u* ip = (const v4u*)(eidx + (size_t)t * 128 + g * 16); Idx r; r.a = ip[0]; r.b = ip[1]; r.c = ip[2]; r.d = ip[3]; return r; }
__device__ __forceinline__ void load_rows(v4u (&R)[16], const Idx& I, const unsigned char* base, unsigned lo) {
#define PR_(i, e) R[i] = *(const v4u*)(base + ((e) * 128u + lo))
    PR_(0, I.a.x); PR_(1, I.a.y); PR_(2, I.a.z); PR_(3, I.a.w); PR_(4, I.b.x); PR_(5, I.b.y); PR_(6, I.b.z); PR_(7, I.b.w);
    PR_(8, I.c.x); PR_(9, I.c.y); PR_(10, I.c.z); PR_(11, I.c.w); PR_(12, I.d.x); PR_(13, I.d.y); PR_(14, I.d.z); PR_(15, I.d.w);
#undef PR_
}
__device__ __forceinline__ void dma_rows(LAS unsigned char* slot, const Idx& I, const unsigned char* base, unsigned lo) {
#define PD_(i, e) __builtin_amdgcn_global_load_lds((const unsigned*)(base + ((e) * 128u + lo)), (LAS unsigned*)(slot + (i) * 1024), 16, 0, 0)
    PD_(0, I.a.x); PD_(1, I.a.y); PD_(2, I.a.z); PD_(3, I.a.w); PD_(4, I.b.x); PD_(5, I.b.y); PD_(6, I.b.z); PD_(7, I.b.w);
    PD_(8, I.c.x); PD_(9, I.c.y); PD_(10, I.c.z); PD_(11, I.c.w); PD_(12, I.d.x); PD_(13, I.d.y); PD_(14, I.d.z); PD_(15, I.d.w);
#undef PD_
}
__device__ __forceinline__ void read_slot(v4u (&R)[16], const LAS unsigned char* slot, int lane) {
#pragma unroll
    for (int i = 0; i < 16; ++i) R[i] = *(const LAS v4u*)(slot + i * 1024 + lane * 16);
}
__device__ __forceinline__ f32x2 dots(const v4u (&R)[16], const float (&hf)[16], int c) {
    float pd[16];
    unsigned carry = R[0][0];
#pragma unroll
    for (int j = 0; j < 16; ++j) { float a = 0.f;
#pragma unroll
        for (int w = 0; w < 4; ++w) { const unsigned uw = (w == 0) ? carry : R[j][w]; const f32x2 lo = __builtin_amdgcn_cvt_pk_f32_fp8((int)uw, false), hh = __builtin_amdgcn_cvt_pk_f32_fp8((int)uw, true);
            a += hf[4 * w] * lo[0] + hf[4 * w + 1] * lo[1] + hf[4 * w + 2] * hh[0] + hf[4 * w + 3] * hh[1]; }
        if (j < 15) { carry = R[j + 1][0]; if (j & 1) asm volatile("" : "+v"(a), "+v"(carry)); }
        pd[j] = a; }
    float w8[8], w4[4], w2[2];
    { const bool up = (c & 4) != 0;
#pragma unroll
      for (int j = 0; j < 8; ++j) { const float send = up ? pd[j] : pd[8 + j]; const float keep = up ? pd[8 + j] : pd[j]; w8[j] = keep + __shfl_xor(send, 4); } }
    { const bool up = (c & 2) != 0;
#pragma unroll
      for (int j = 0; j < 4; ++j) { const float send = up ? w8[j] : w8[4 + j]; const float keep = up ? w8[4 + j] : w8[j]; w4[j] = keep + __shfl_xor(send, 2); } }
    { const bool up = (c & 1) != 0;
#pragma unroll
      for (int j = 0; j < 2; ++j) { const float send = up ? w4[j] : w4[2 + j]; const float keep = up ? w4[2 + j] : w4[j]; w2[j] = keep + __shfl_xor(send, 1); } }
    return (f32x2){w2[0], w2[1]};
}
template <int CTRL> __device__ __forceinline__ float dppf(float v) { return __builtin_bit_cast(float, __builtin_amdgcn_update_dpp(0, __builtin_bit_cast(int, v), CTRL, 0xf, 0xf, true)); }
template <int CTRL> __device__ __forceinline__ int dppi(int v) { return __builtin_amdgcn_update_dpp(0, v, CTRL, 0xf, 0xf, true); }
__device__ __forceinline__ float xor16f(float v, bool oddrow) { const auto r = __builtin_amdgcn_permlane16_swap(__builtin_bit_cast(unsigned, v), __builtin_bit_cast(unsigned, v), false, false); return __builtin_bit_cast(float, oddrow ? r[0] : r[1]); }
__device__ __forceinline__ float xor32f(float v, bool upper) { const auto r = __builtin_amdgcn_permlane32_swap(__builtin_bit_cast(unsigned, v), __builtin_bit_cast(unsigned, v), false, false); return __builtin_bit_cast(float, upper ? r[0] : r[1]); }
__device__ __forceinline__ f32x2 idots(const v4u (&R)[16], const v4u& H, int c) {
    int pd[16];
#pragma unroll
    for (int j = 0; j < 16; ++j) { int a = __builtin_amdgcn_sdot4((int)R[j].x, (int)H.x, 0, false); a = __builtin_amdgcn_sdot4((int)R[j].y, (int)H.y, a, false); a = __builtin_amdgcn_sdot4((int)R[j].z, (int)H.z, a, false); a = __builtin_amdgcn_sdot4((int)R[j].w, (int)H.w, a, false); pd[j] = a; }
    int w8[8], w4[4], w2[2];
    { const bool up = (c & 4) != 0;
#pragma unroll
      for (int j = 0; j < 8; ++j) { const int send = up ? pd[j] : pd[8 + j]; const int keep = up ? pd[8 + j] : pd[j]; w8[j] = keep + dppi<0x141>(send); } }
    { const bool up = (c & 2) != 0;
#pragma unroll
      for (int j = 0; j < 4; ++j) { const int send = up ? w8[j] : w8[4 + j]; const int keep = up ? w8[4 + j] : w8[j]; w4[j] = keep + dppi<0x4E>(send); } }
    { const bool up = (c & 1) != 0;
#pragma unroll
      for (int j = 0; j < 2; ++j) { const int send = up ? w4[j] : w4[2 + j]; const int keep = up ? w4[2 + j] : w4[j]; w2[j] = keep + dppi<0xB1>(send); } }
    return (f32x2){(float)w2[0], (float)w2[1]};
}
__device__ __forceinline__ f32x2 axpys(const v4u (&R)[16], const v4u& c0, const v4u& c1, int g) {
    const unsigned cw[8] = {c0.x, c0.y, c0.z, c0.w, c1.x, c1.y, c1.z, c1.w};
    float cf[16];
#pragma unroll
    for (int k = 0; k < 8; ++k) { cf[2 * k] = bflo(cw[k]); cf[2 * k + 1] = bfhi(cw[k]); }
    float acc[16];
#pragma unroll
    for (int k = 0; k < 16; ++k) acc[k] = 0.f;
#pragma unroll
    for (int j = 0; j < 16; ++j) {
#pragma unroll
        for (int w = 0; w < 4; ++w) { const unsigned vw = R[j][w]; const f32x2 lo = __builtin_amdgcn_cvt_pk_f32_fp8((int)vw, false), hh = __builtin_amdgcn_cvt_pk_f32_fp8((int)vw, true);
            acc[4 * w] += cf[j] * lo[0]; acc[4 * w + 1] += cf[j] * lo[1]; acc[4 * w + 2] += cf[j] * hh[0]; acc[4 * w + 3] += cf[j] * hh[1]; } if ((j & 3) == 3) __builtin_amdgcn_sched_barrier(0); }
    float w8[8], w4[4], w2[2];
    { const bool up = (g & 4) != 0;
#pragma unroll
      for (int j = 0; j < 8; ++j) { const float send = up ? acc[j] : acc[8 + j]; const float keep = up ? acc[8 + j] : acc[j]; w8[j] = keep + xor32f(send, up); } }
    { const bool up = (g & 2) != 0;
#pragma unroll
      for (int j = 0; j < 4; ++j) { const float send = up ? w8[j] : w8[4 + j]; const float keep = up ? w8[4 + j] : w8[j]; w4[j] = keep + xor16f(send, up); } }
    { const bool up = (g & 1) != 0;
#pragma unroll
      for (int j = 0; j < 2; ++j) { const float send = up ? w4[j] : w4[2 + j]; const float keep = up ? w4[2 + j] : w4[j]; w2[j] = keep + dppf<0x128>(send); } }
    return (f32x2){w2[0], w2[1]};
}
}

struct Frame {
    LAS unsigned char* lds; volatile LAS unsigned* MISC; gu32* ctl;
    int tid, lane, wave, vcu, G;
};
struct Args { const void* in[19]; float* out; unsigned char* ws; int ph_lo, ph_hi, dry, pad; };

__device__ __forceinline__ void p0_transpose_item(const float* W, int K, int N, bf16* WT, int k0, int n0, int drow0, const float* gain, LAS float* scr, int lane) {
#pragma unroll 8
    for (int i = 0; i < 32; ++i) { const int kk = 2 * i + (lane >> 5); float v = W[(size_t)(k0 + kk) * N + n0 + (lane & 31)]; if (gain) v *= gain[k0 + kk]; scr[kk * 33 + (lane & 31)] = v; }
    LDS_WAIT(); asm volatile("" ::: "memory");
    const int c = lane & 7;
#pragma unroll
    for (int j = 0; j < 4; ++j) { const int n = (lane >> 3) + 8 * j; const LAS float* s = scr + (8 * c) * 33 + n;
        v4u o; o.x = pk2(s[0 * 33], s[1 * 33]); o.y = pk2(s[2 * 33], s[3 * 33]); o.z = pk2(s[4 * 33], s[5 * 33]); o.w = pk2(s[6 * 33], s[7 * 33]);
        *(v4u*)(WT + (size_t)(drow0 + n) * K + k0 + 8 * c) = o; }
    LDS_WAIT(); asm volatile("" ::: "memory");
}

#define Xin ((const float*)args.in[0])
#define cin ((const float*)args.in[1])
#define POSin ((const int*)args.in[2])
#define w_ada ((const float*)args.in[3])
#define b_ada ((const float*)args.in[4])
#define g_mix ((const float*)args.in[5])
#define w_in ((const float*)args.in[6])
#define g_qa ((const float*)args.in[7])
#define w_uq ((const float*)args.in[8])
#define g_kva ((const float*)args.in[9])
#define w_ukv ((const float*)args.in[10])
#define rel_bias ((const float*)args.in[11])
#define w_out ((const float*)args.in[12])
#define g_ffn ((const float*)args.in[13])
#define w_pq ((const float*)args.in[14])
#define peer_keys ((const float*)args.in[15])
#define peer_u ((const float*)args.in[16])
#define peer_v ((const float*)args.in[17])
#define g_final ((const float*)args.in[18])
#define Wt_in ((bf16*)(ws + WS_W_IN))
#define Wt_uq ((bf16*)(ws + WS_W_UQ))
#define Wt_ukv ((bf16*)(ws + WS_W_UKV))
#define Wt_out ((bf16*)(ws + WS_W_OUT))
#define Wt_pq ((bf16*)(ws + WS_W_PQ))
#define PU ((unsigned char*)(ws + WS_PU))
#define SU ((float*)(ws + WS_SU))
#define SV ((float*)(ws + WS_SV))
#define PV ((unsigned char*)(ws + WS_PV))
#define HB ((bf16*)(ws + WS_HB))
#define CQ ((bf16*)(ws + WS_CQ))
#define CKV ((bf16*)(ws + WS_CKV))
#define KRF ((float*)(ws + WS_KRF))
#define KRB ((bf16*)(ws + WS_KRB))
#define MQ ((bf16*)(ws + WS_MQ))
#define MK ((bf16*)(ws + WS_MK))
#define MV ((bf16*)(ws + WS_MV))
#define QM ((bf16*)(ws + WS_QM))
#define KN ((bf16*)(ws + WS_KN))
#define VM ((bf16*)(ws + WS_VM))
#define ROPET ((float*)(ws + WS_ROPE))
#define MOD ((float*)(ws + WS_MOD))
#define KMEAN ((float*)(ws + OFF_KSUM))
#define KH ((bf16*)(ws + WS_KH))
#define KL ((bf16*)(ws + WS_KL))
#define SSQ_Q ((float*)(ws + OFF_SSQ_Q))
#define SSQ_KV ((float*)(ws + OFF_SSQ_KV))
#define SSQ_1 ((float*)(ws + OFF_SSQ_1))
#define PQ ((float*)(ws + WS_PQ))
#define EIDX ((int*)(ws + WS_EIDX))
#define EGATE ((float*)(ws + WS_EGATE))
#define COEF ((float*)(ws + WS_COEF))
#define YB ((const bf16*)(ws + WS_Y))
#define LISTP ((unsigned short*)(ws + WS_LIST))
#define SELM ((unsigned*)(ws + WS_SELM))
#define QPP ((unsigned short*)(ws + WS_QP))
#define POP ((bf16*)((unsigned char*)args.out + PO_OFF))
#define PMLP ((float*)((unsigned char*)args.out + PML_OFF))
#define HQ ((unsigned char*)(ws + WS_HQ))
#define HS ((float*)(ws + WS_HS))
#define ESU ((float*)(ws + WS_ESU))
#define ESV ((float*)(ws + WS_ESV))
#define SSQ_2 ((float*)(ws + OFF_SSQ_2))
#define PA_SLICE(sl) ((float*)(ws + WS_PQ + (size_t)(sl) * 8 * MiB))
#define X1 (args.out)
#define OUTp (args.out)
__device__ __forceinline__ void peer_quant_one(const Args& args, unsigned char* ws, int r, int plane, const f32x4& v0, const f32x4& v1, const f32x4& v2, const f32x4& v3) {
    const int half = r >= 16384, row = r - half * 16384;
    float am = 0.f;
#pragma unroll
    for (int j = 0; j < 4; ++j) am = fmaxf(am, fmaxf(fmaxf(fabsf(v0[j]), fabsf(v1[j])), fmaxf(fabsf(v2[j]), fabsf(v3[j]))));
    am = wave_max(am);
    v4u o4;
    if (half) {
        const float inv = am > 0.f ? 448.0f / am : 0.f; int w;
        w = __builtin_amdgcn_cvt_pk_fp8_f32(v0[0] * inv, v0[1] * inv, 0, false); w = __builtin_amdgcn_cvt_pk_fp8_f32(v0[2] * inv, v0[3] * inv, w, true); o4.x = (unsigned)w;
        w = __builtin_amdgcn_cvt_pk_fp8_f32(v1[0] * inv, v1[1] * inv, 0, false); w = __builtin_amdgcn_cvt_pk_fp8_f32(v1[2] * inv, v1[3] * inv, w, true); o4.y = (unsigned)w;
        w = __builtin_amdgcn_cvt_pk_fp8_f32(v2[0] * inv, v2[1] * inv, 0, false); w = __builtin_amdgcn_cvt_pk_fp8_f32(v2[2] * inv, v2[3] * inv, w, true); o4.z = (unsigned)w;
        w = __builtin_amdgcn_cvt_pk_fp8_f32(v3[0] * inv, v3[1] * inv, 0, false); w = __builtin_amdgcn_cvt_pk_fp8_f32(v3[2] * inv, v3[3] * inv, w, true); o4.w = (unsigned)w;
    } else {
        const float inv = am > 0.f ? 127.0f / am : 0.f;
#define Q8_(v) ((unsigned)(__float2int_rn((v) * inv)) & 0xffu)
        o4.x = Q8_(v0[0]) | (Q8_(v0[1]) << 8) | (Q8_(v0[2]) << 16) | (Q8_(v0[3]) << 24); o4.y = Q8_(v1[0]) | (Q8_(v1[1]) << 8) | (Q8_(v1[2]) << 16) | (Q8_(v1[3]) << 24);
        o4.z = Q8_(v2[0]) | (Q8_(v2[1]) << 8) | (Q8_(v2[2]) << 16) | (Q8_(v2[3]) << 24); o4.w = Q8_(v3[0]) | (Q8_(v3[1]) << 8) | (Q8_(v3[2]) << 16) | (Q8_(v3[3]) << 24);
#undef Q8_
    }
    *(v4u*)((half ? PV : PU) + (size_t)(plane >> 3) * (16384 * 128) + (size_t)row * 128 + (plane & 7) * 16) = o4;
    if (plane == 0) { if (half) SV[row] = am * (1.0f / 448.0f); else SU[row] = am * (1.0f / 127.0f); }
}
__device__ __forceinline__ void peer_quant_rows(const Args& args, unsigned char* ws, int r_lo, int r_hi, int plane) {
    if (r_lo >= r_hi) return;
#define QSRC_(r) (((r) >= 16384 ? peer_v + (size_t)((r) - 16384) * D : peer_u + (size_t)(r) * D) + plane * 16)
#define QLD_(X, r) do { const int rr_ = (r) < r_last ? (r) : r_last; const float* p_ = QSRC_(rr_); X##0 = *(const f32x4*)p_; X##1 = *(const f32x4*)(p_ + 4); X##2 = *(const f32x4*)(p_ + 8); X##3 = *(const f32x4*)(p_ + 12); } while (0)
    const int r_last = r_hi - 1;
    f32x4 a0, a1, a2, a3, b0, b1, b2, b3, c0, c1, c2, c3, d0, d1, d2, d3;
    QLD_(a, r_lo); QLD_(b, r_lo + 1); QLD_(c, r_lo + 2); QLD_(d, r_lo + 3);
#pragma unroll 1
    for (int r = r_lo; r < r_hi; r += 4) {
        peer_quant_one(args, ws, r, plane, a0, a1, a2, a3); QLD_(a, r + 4);
        if (r + 1 < r_hi) peer_quant_one(args, ws, r + 1, plane, b0, b1, b2, b3);
        QLD_(b, r + 5);
        if (r + 2 < r_hi) peer_quant_one(args, ws, r + 2, plane, c0, c1, c2, c3);
        QLD_(c, r + 6);
        if (r + 3 < r_hi) peer_quant_one(args, ws, r + 3, plane, d0, d1, d2, d3);
        QLD_(d, r + 7);
    }
#undef QLD_
#undef QSRC_
}

__global__ void __launch_bounds__(NWAVES * 64, 2) mk_fwd(Args args) {
    extern __shared__ __attribute__((aligned(16))) unsigned char lds_raw[];
    Frame F;
    F.lds = (LAS unsigned char*)lds_raw; F.MISC = (volatile LAS unsigned*)(F.lds + MISC_OFF);
    F.tid = threadIdx.x; F.lane = F.tid & 63; F.wave = __builtin_amdgcn_readfirstlane(F.tid >> 6);
    F.G = gridDim.x; { const int bx = blockIdx.x; F.vcu = (F.G % 8 == 0) ? (bx % 8) * (F.G / 8) + bx / 8 : bx; }
    unsigned char* ws = args.ws; F.ctl = (gu32*)(ws + WS_CTL);
    for (int u = F.tid; u < (LDS_BYTES - LDSCTL_OFF) / 4; u += NWAVES * 64) ((LAS unsigned*)(F.lds + LDSCTL_OFF))[u] = 0u;
    __syncthreads();
    XcdBarrier bar; bar.bar = (unsigned*)(F.ctl + CW_BAR); bar.x = 0; bar.st = nullptr;
    if (MK_LAUNCHES == 1) bar = xcd_barrier_post((unsigned*)(F.ctl + CW_BAR), F.MISC + 8);
    const int lo = args.ph_lo, hi = args.ph_hi;
#ifndef PH_MASK
#define PH_MASK 0x7fff
#endif
#define IN(k) (((PH_MASK >> (k)) & 1) && lo <= (k) && (k) < hi)
#define SEAM(k) do { if (IN(k) && IN((k) + 1)) xcd_barrier(bar); } while (0)
    const int gw = F.vcu * NWAVES + F.wave, NGW = F.G * NWAVES;
    const int NGT = F.G * NWAVES * 64;
#define gt (F.vcu * (NWAVES * 64) + ptid)

    if (IN(0)) {
        const int ptid = opaque_tid(), plane = ptid & 63; (void)plane;
        if (F.vcu < 96) {
            LAS float* sc = (LAS float*)(F.lds);
            LAS float* red = sc + 4096;
            for (int i = ptid; i < NB * D; i += 512) { const float v = cin[i]; sc[i] = v / (1.f + __expf(-v)); }
            __syncthreads();
            const int col = F.vcu * 64 + plane; float a0 = 0, a1 = 0, a2 = 0, a3 = 0;
            for (int k0 = F.wave * 128; k0 < F.wave * 128 + 128; k0 += 16) { float wv[16];
#pragma unroll
                for (int u = 0; u < 16; ++u) wv[u] = w_ada[(size_t)(k0 + u) * 6 * D + col];
#pragma unroll
                for (int u = 0; u < 16; ++u) { const int k = k0 + u; a0 += sc[k] * wv[u]; a1 += sc[1024 + k] * wv[u]; a2 += sc[2048 + k] * wv[u]; a3 += sc[3072 + k] * wv[u]; } }
            red[(F.wave * 4 + 0) * 64 + plane] = a0; red[(F.wave * 4 + 1) * 64 + plane] = a1; red[(F.wave * 4 + 2) * 64 + plane] = a2; red[(F.wave * 4 + 3) * 64 + plane] = a3;
            __syncthreads();
            if (ptid < 256) { const int bb = ptid >> 6, l = ptid & 63; float s = b_ada[F.vcu * 64 + l];
#pragma unroll
                for (int w = 0; w < 8; ++w) s += red[(w * 4 + bb) * 64 + l];
                MOD[bb * 6 * D + F.vcu * 64 + l] = s; }
            __syncthreads();
        }
        {
            LAS float* scr = (LAS float*)(F.lds + F.wave * 16384);
            constexpr int I_IN = 16 * 81, I_UQ = 12 * 24, I_UKV = 4 * 32, I_OUT = 16 * 32, I_PQ = 16 * 32;
            for (int it = gw; it < I_IN + I_UQ + I_UKV + I_OUT + I_PQ; it += NGW) {
                int r = it;
                if (r < I_IN) { const int kb = r / 81, nb = r % 81, n0 = nb * 32; const int dr = (n0 < 1024) ? n0 : (n0 == 1024 ? 2560 : n0 - 32);
                    p0_transpose_item(w_in, 1024, 2592, Wt_in, kb * 64, n0, dr, nullptr, scr, plane); continue; } r -= I_IN;
                if (r < I_UQ) { const int kb = r / 24, nb = r % 24; p0_transpose_item(w_uq, 768, 768, Wt_uq, kb * 64, nb * 32, nb * 32, g_qa, scr, plane); continue; } r -= I_UQ;
                if (r < I_UKV) { const int kb = r / 32, nb = r % 32; p0_transpose_item(w_ukv, 256, 1024, Wt_ukv, kb * 64, nb * 32, nb * 32, g_kva, scr, plane); continue; } r -= I_UKV;
                if (r < I_OUT) { const int kb = r / 32, nb = r % 32; p0_transpose_item(w_out, 1024, 1024, Wt_out, kb * 64, nb * 32, nb * 32, nullptr, scr, plane); continue; } r -= I_OUT;
                { const int kb = r / 32, nb = r % 32; p0_transpose_item(w_pq, 1024, 1024, Wt_pq, kb * 64, nb * 32, nb * 32, nullptr, scr, plane); }
            }
            for (int i = gt; i < 224 * 1024 / 8; i += NGT) *(v4u*)(Wt_in + (size_t)2592 * 1024 + (size_t)i * 8) = (v4u){0u, 0u, 0u, 0u};
        }
        if (F.G != 256) { const int per = (32768 + NGW - 1) / NGW; const int lo = gw * per, hi = lo + per < 32768 ? lo + per : 32768; peer_quant_rows(args, ws, lo, hi, plane); }
        for (int i = gt; i < 8 * 2 * 128 * 64; i += NGT) { const float v = peer_keys[i]; const unsigned hb = f2bf(v); const float r = v - __builtin_bit_cast(float, hb << 16); KH[i] = (bf16)hb; KL[i] = (bf16)f2bf(r); }
        for (int i = gt; i < T * 16; i += NGT) { const int t = i >> 4, j = i & 15; const float inv = powf(10000.0f, -(float)j / 16.0f); const float ang = (float)POSin[t] * inv;
            ROPET[(size_t)i * 2] = cosf(ang); ROPET[(size_t)i * 2 + 1] = sinf(ang); }
    }
    SEAM(0);
    if (IN(1)) {
        const int ptid = opaque_tid(), plane = ptid & 63; (void)plane;
        for (int m = gw; m < T; m += NGW) {
            const int b = m / S; const f32x4* xr = (const f32x4*)(Xin + (size_t)m * D) + plane; f32x4 v[4]; float s = 0.f;
#pragma unroll
            for (int j = 0; j < 4; ++j) { v[j] = xr[64 * j]; s += v[j][0] * v[j][0] + v[j][1] * v[j][1] + v[j][2] * v[j][2] + v[j][3] * v[j][3]; }
            const float rs = 1.0f / sqrtf(wave_sum(s) * (1.f / D) + EPS);
            unsigned long long* o8 = (unsigned long long*)(HB + (size_t)m * D) + plane;
#pragma unroll
            for (int j = 0; j < 4; ++j) { const int c = j * 256 + plane * 4; const f32x4 g = *(const f32x4*)(g_mix + c), sc = *(const f32x4*)(MOD + b * 6 * D + D + c), sh = *(const f32x4*)(MOD + b * 6 * D + c);
                const f32x4 hv = v[j] * rs * g * (sc + 1.f) + sh;
                o8[64 * j] = (unsigned long long)pk2(hv[0], hv[1]) | ((unsigned long long)pk2(hv[2], hv[3]) << 32); }
        }
    }
    SEAM(1);
    if (IN(2)) {
        const int ptid = opaque_tid(), plane = ptid & 63; (void)plane;
        pg8::Gemm g{HB, Wt_in, T, NZ, D, D}; pg8::StaticOrder So; So.init(T, NZ, F.G, (int)blockIdx.x);
        epi::EpiZ E{ws, args.dry};
        pg8::gemm_phase<epi::EpiZ, pg8::StaticOrder, true, true>(F.lds, g, So, E);
        if (F.G == 256 && blockIdx.x >= 192) { const int hw = ((int)blockIdx.x - 192) * NWAVES + F.wave; peer_quant_rows(args, ws, hw * QR2, (hw + 1) * QR2, plane); }
    }
    SEAM(2);
    if (IN(3)) {
        const int ptid = opaque_tid(), plane = ptid & 63; (void)plane;
        for (int i = gt; i < T * 16; i += NGT) { const int t = i >> 4, j = i & 15; const float cs = ROPET[(size_t)i * 2], sn = ROPET[(size_t)i * 2 + 1];
            const float x1 = KRF[(size_t)t * 32 + j], x2 = KRF[(size_t)t * 32 + 16 + j];
            KRB[(size_t)t * 32 + j] = (bf16)f2bf(x1 * cs - x2 * sn); KRB[(size_t)t * 32 + 16 + j] = (bf16)f2bf(x2 * cs + x1 * sn); }
        { const int lane = plane;
        unsigned* cntp = (unsigned*)(F.ctl + CW_CNT);
        for (int it = gw; it < 32 * 64; it += NGW) {
            const int bh = it >> 6, grp = it & 63, b = bh >> 3, h = bh & 7, q = grp * 64 + lane, qb = (grp * 64) >> 8;
            const size_t tq = (size_t)b * S + q;
            unsigned mask;
            if (qb <= 3) mask = (1u << qb) - 1u;
            else {
                float qf[64];
                { const v4u* qp = (const v4u*)(MQ + tq * 512 + h * 64);
#pragma unroll
                  for (int i = 0; i < 8; ++i) { const v4u w = qp[i]; qf[8 * i] = bflo(w.x); qf[8 * i + 1] = bfhi(w.x); qf[8 * i + 2] = bflo(w.y); qf[8 * i + 3] = bfhi(w.y); qf[8 * i + 4] = bflo(w.z); qf[8 * i + 5] = bfhi(w.z); qf[8 * i + 6] = bflo(w.w); qf[8 * i + 7] = bfhi(w.w); } }
                float v1 = -INFINITY, v2 = -INFINITY, v3 = -INFINITY; int i1 = 0, i2 = 0, i3 = 0;
#pragma unroll 1
                for (int n = 0; n < qb; ++n) { const float* km = KMEAN + ((size_t)(b * 8 + h) * 16 + n) * 64; float a = 0.f;
#pragma unroll
                    for (int d = 0; d < 64; ++d) a += qf[d] * km[d];
                    if (a > v1) { v3 = v2; i3 = i2; v2 = v1; i2 = i1; v1 = a; i1 = n; } else if (a > v2) { v3 = v2; i3 = i2; v2 = a; i2 = n; } else if (a > v3) { v3 = a; i3 = n; } }
                const unsigned mk = (1u << i1) | (1u << i2) | (1u << i3);
                mask = mk;
            }
            SELM[tq * 8 + h] = mask;
#pragma unroll 1
            for (int n = 0; n < qb; ++n) {
                const bool has = (mask >> n) & 1u; const unsigned long long bal = __ballot(has);
                if (bal) {
                    const int leader = __builtin_ctzll(bal); unsigned base = 0;
                    if (lane == leader) base = __hip_atomic_fetch_add(cntp + bh * 16 + n, (unsigned)__builtin_popcountll(bal), __ATOMIC_RELAXED, __HIP_MEMORY_SCOPE_AGENT);
                    base = (unsigned)__shfl((int)base, leader);
                    if (has) { const unsigned pos = base + (unsigned)__builtin_popcountll(bal & ((1ull << lane) - 1ull)); const unsigned k = (unsigned)__builtin_popcount(mask & ((1u << n) - 1u));
                        LISTP[((size_t)bh * 15 + n) * LIST_CAP + pos] = (unsigned short)((unsigned)q | (k << 12)); QPP[(tq * 8 + h) * 4 + k] = (unsigned short)pos; }
                }
            }
        }
        }
        if (F.G == 256 && blockIdx.x >= 192) { const int hw = ((int)blockIdx.x - 192) * NWAVES + F.wave; peer_quant_rows(args, ws, 512 * QR2 + hw * (64 - QR2), 512 * QR2 + (hw + 1) * (64 - QR2), plane); }
        { pg8::Gemm g{CQ, Wt_uq, T, 768, 768, 768}; pg8::StaticOrder So; So.init(T, 768, F.G, (int)blockIdx.x);
          epi::EpiQ E{ws};
          pg8::gemm_phase<epi::EpiQ, pg8::StaticOrder, true, true>(F.lds, g, So, E); }
        { pg8::Gemm g{CKV, Wt_ukv, T, 1024, 256, 256}; pg8::StaticOrder So; So.init(T, 1024, F.G, (int)blockIdx.x);
          epi::EpiKV E{ws};
          pg8::gemm_phase<epi::EpiKV, pg8::StaticOrder, true, true>(F.lds, g, So, E); }
    }
    SEAM(3);
    LAS unsigned* tcnt = (LAS unsigned*)(F.lds + 98304); LAS unsigned* tpb = tcnt + 480; LAS unsigned* tsub = tpb + 480; LAS unsigned* tbc = tsub + 484;
    if (IN(5) || IN(6)) {
        const int ptid = opaque_tid();
        if (IN(5)) {
            for (int v = F.vcu; v < 256; v += F.G) { const int bh = v >> 3, s = v & 7, b = bh >> 3, h = bh & 7;
                att::attn_unit<0>(F.lds, b, h, 15 - s, QM, KN, KRB, VM, ROPET, nullptr, HB, 0);
                att::attn_unit<0>(F.lds, b, h, s, QM, KN, KRB, VM, ROPET, nullptr, HB, 0); }
        }
        const unsigned* cntp = (const unsigned*)(F.ctl + CW_CNT);
        for (int i = ptid; i < 480; i += 512) tcnt[i] = __hip_atomic_load(cntp + (i / 15) * 16 + (i % 15), __ATOMIC_RELAXED, __HIP_MEMORY_SCOPE_AGENT);
        __syncthreads();
        if (ptid < 64) {
            unsigned c8[8], pb = 0, sp = 0;
#pragma unroll
            for (int j = 0; j < 8; ++j) { const int i = ptid * 8 + j; c8[j] = (i < 480) ? tcnt[i] : 0u; pb += c8[j]; sp += (((c8[j] + 31u) >> 5) + 15u) >> 4; }
            unsigned ipb = pb, isp = sp;
#pragma unroll
            for (int o = 1; o < 64; o <<= 1) { const unsigned a_ = (unsigned)__shfl_up((int)ipb, o), b_ = (unsigned)__shfl_up((int)isp, o); if (ptid >= o) { ipb += a_; isp += b_; } }
            unsigned epb = ipb - pb, esp = isp - sp;
#pragma unroll
            for (int j = 0; j < 8; ++j) { const int i = ptid * 8 + j; if (i < 480) { tpb[i] = epb; tsub[i] = esp; } else if (i == 480) tsub[480] = esp; epb += c8[j]; esp += (((c8[j] + 31u) >> 5) + 15u) >> 4; }
        }
        __syncthreads();
    }
    if (IN(5)) {
        const int ptid = opaque_tid();
        const unsigned NS = tsub[480]; unsigned* qc = (unsigned*)(F.ctl + CW_QCTR2); int last_h = -1;
        for (;;) {
            if (ptid == 0) *tbc = __hip_atomic_fetch_add(qc, 1u, __ATOMIC_RELAXED, __HIP_MEMORY_SCOPE_AGENT);
            __syncthreads();
            const unsigned sidx = *tbc;
            __syncthreads();
            if (sidx >= NS) break;
            int lo_ = 0, hi_ = 480;
            while (hi_ - lo_ > 1) { const int mid = (lo_ + hi_) >> 1; if (tsub[mid] <= sidx) lo_ = mid; else hi_ = mid; }
            const int i = lo_, bh = i / 15, n = i % 15;
            att::moba_past_sub(F.lds, bh >> 3, bh & 7, n, (int)(sidx - tsub[i]), tcnt[i], tpb[i], LISTP + (size_t)i * LIST_CAP, MQ, MK, MV, rel_bias, POP, PMLP, (bh & 7) != last_h); last_h = bh & 7;
        }
    }
    SEAM(5);
    if (IN(6)) {
        att::MergeCtx mc{SELM, QPP, POP, PMLP, tpb, 1};
        for (int v = F.vcu; v < 256; v += F.G) { const int bh = v >> 3, s = v & 7, b = bh >> 3, h = bh & 7;
            mc.fill_table = 1; att::moba_own_unit(F.lds, b, h, 15 - s, MQ, MK, MV, rel_bias, HB, 512, &mc);
            mc.fill_table = 0; att::moba_own_unit(F.lds, b, h, s, MQ, MK, MV, rel_bias, HB, 512, &mc); }
    }
    SEAM(6);
    if (IN(7)) {
        const int ptid = opaque_tid(), plane = ptid & 63; (void)plane;
        pg8::Gemm g{HB, Wt_out, T, D, D, D}; pg8::StaticOrder So; So.init(T, D, F.G, (int)blockIdx.x);
        epi::EpiRes E{ws};
        pg8::gemm_phase<epi::EpiRes, pg8::StaticOrder, true, true>(F.lds, g, So, E);
    }
    SEAM(7);
    if (IN(8)) {
        const int ptid = opaque_tid(), plane = ptid & 63; (void)plane;
        for (int m = gw; m < T; m += NGW) {
            const int b = m / S; const f32x4* xr = (const f32x4*)(Xin + (size_t)m * D) + plane; const v2u* yr = (const v2u*)(YB + (size_t)m * D) + plane;
            f32x4 v1[4]; float ss = 0.f;
#pragma unroll
            for (int j = 0; j < 4; ++j) { const f32x4 xv = xr[64 * j]; const v2u yw = yr[64 * j]; const unsigned y0 = yw.x, y1 = yw.y;
                v1[j] = (f32x4){xv[0] + bflo(y0), xv[1] + bfhi(y0), xv[2] + bflo(y1), xv[3] + bfhi(y1)};
                ss += v1[j][0] * v1[j][0] + v1[j][1] * v1[j][1] + v1[j][2] * v1[j][2] + v1[j][3] * v1[j][3]; }
            const float rs = 1.0f / sqrtf(wave_sum(ss) * (1.f / D) + EPS);
            unsigned long long* o8 = (unsigned long long*)(HB + (size_t)m * D) + plane;
            f32x4 hq[4];
#pragma unroll
            for (int j = 0; j < 4; ++j) { const int c = j * 256 + plane * 4; const f32x4 v = v1[j]; const f32x4 g = *(const f32x4*)(g_ffn + c), sc = *(const f32x4*)(MOD + b * 6 * D + 4 * D + c), sh = *(const f32x4*)(MOD + b * 6 * D + 3 * D + c);
                const f32x4 hv = v * rs * g * (sc + 1.f) + sh;
                o8[64 * j] = (unsigned long long)pk2(hv[0], hv[1]) | ((unsigned long long)pk2(hv[2], hv[3]) << 32); hq[j] = hv; }
            float am = 0.f;
#pragma unroll
            for (int j = 0; j < 4; ++j) am = fmaxf(am, fmaxf(fmaxf(fabsf(hq[j][0]), fabsf(hq[j][1])), fmaxf(fabsf(hq[j][2]), fabsf(hq[j][3]))));
            am = wave_max(am);
            const float qi = am > 0.f ? 127.0f / am : 0.f;
#pragma unroll
            for (int j = 0; j < 4; ++j) { const int c = j * 256 + plane * 4;
                *(unsigned*)(HQ + (size_t)m * D + c) = ((unsigned)__float2int_rn(hq[j][0] * qi) & 0xffu) | (((unsigned)__float2int_rn(hq[j][1] * qi) & 0xffu) << 8) | (((unsigned)__float2int_rn(hq[j][2] * qi) & 0xffu) << 16) | (((unsigned)__float2int_rn(hq[j][3] * qi) & 0xffu) << 24); }
            if (plane == 0) HS[m] = am * (1.0f / 127.0f);
        }
    }
    SEAM(8);
    if (IN(9)) {
        const int ptid = opaque_tid(), plane = ptid & 63; (void)plane;
        pg8::Gemm g{HB, Wt_pq, T, D, D, D}; pg8::StaticOrder So; So.init(T, D, F.G, (int)blockIdx.x);
        epi::EpiF32 E{PQ, D};
        pg8::gemm_phase<epi::EpiF32, pg8::StaticOrder, true, true>(F.lds, g, So, E);
    }
    SEAM(9);
    if (IN(10)) {
        const int ptid = opaque_tid(), plane = ptid & 63; (void)plane;
        const int lane = plane, r32 = lane & 31, hi = lane >> 5;
        LAS unsigned* dl = (LAS unsigned*)(F.lds + F.wave * 4096);
        const int h = F.vcu & 7; LAS unsigned char* khs = F.lds + 32768; LAS unsigned char* kls = khs + 256 * 144;
        for (int pc = ptid; pc < 2 * 256 * 8; pc += 512) { const int tb_ = pc >= 2048, q_ = pc & 2047, row = q_ >> 3, ch = q_ & 7;
            *(LAS v4u*)((tb_ ? kls : khs) + row * 144 + ch * 16) = *(const v4u*)((tb_ ? KL : KH) + ((size_t)(h * 256 + row)) * 64 + ch * 8); }
        __syncthreads();
        for (int it2 = 0; it2 < (T / 32) * 8 / (F.G * NWAVES); ++it2) {
            const int t = (((F.vcu >> 3) * ((T / 32) * 8 / (F.G * NWAVES)) + it2) * NWAVES + F.wave) * 32 + r32;
            float s0[16], s1[16];
#pragma unroll
            for (int p = 0; p < 2; ++p) {
                bf16x8 qh[4], ql[4];
#pragma unroll
                for (int ks = 0; ks < 4; ++ks) { const float* qp = PQ + (size_t)t * 1024 + h * 128 + p * 64 + ks * 16 + hi * 8; const f32x4 a = *(const f32x4*)qp, c = *(const f32x4*)(qp + 4);
                    const float qv[8] = {a[0], a[1], a[2], a[3], c[0], c[1], c[2], c[3]};
#pragma unroll
                    for (int j = 0; j < 8; ++j) { const unsigned hb = f2bf(qv[j]); qh[ks][j] = (short)hb; ql[ks][j] = (short)f2bf(qv[j] - __builtin_bit_cast(float, hb << 16)); } }
                float m[16];
                f32x16 accs[4];
#pragma unroll
                for (int nb = 0; nb < 4; ++nb) {
                    f32x16 acc = {};
                    const int ko = (p * 128 + nb * 32 + r32) * 144 + hi * 16;
#pragma unroll
                    for (int ks = 0; ks < 4; ++ks) { const bf16x8 kh = *(const LAS bf16x8*)(khs + ko + ks * 32), kl = *(const LAS bf16x8*)(kls + ko + ks * 32);
                        acc = __builtin_amdgcn_mfma_f32_32x32x16_bf16(kh, qh[ks], acc, 0, 0, 0); acc = __builtin_amdgcn_mfma_f32_32x32x16_bf16(kl, qh[ks], acc, 0, 0, 0); acc = __builtin_amdgcn_mfma_f32_32x32x16_bf16(kh, ql[ks], acc, 0, 0, 0); }
                    accs[nb] = acc;
                }
#pragma unroll
                for (int nb = 0; nb < 4; ++nb) {
                    float v[16];
#pragma unroll
                    for (int r = 0; r < 16; ++r) { const unsigned n = (unsigned)(nb * 32 + (r & 3) + 8 * (r >> 2)) | ((unsigned)hi << 2); const float av = accs[nb][r]; v[r] = __builtin_bit_cast(float, (__builtin_bit_cast(unsigned, av) & ~127u) | n); }
                    srt::sort_desc<16>(v);
                    if (nb == 0) {
#pragma unroll
                        for (int r = 0; r < 16; ++r) m[r] = v[r]; }
                    else srt::merge16(m, v);
                }
                srt::merge_partner(m, hi != 0);
#pragma unroll
                for (int r = 0; r < 16; ++r) { if (p == 0) s0[r] = m[r]; else s1[r] = m[r]; }
            }
            float c0[16], c1[16];
            srt::cand_fill<0>(s0, s1, hi, c0, c1);
            srt::sort_desc<16>(c0); srt::sort_desc<16>(c1); srt::merge16(c0, c1); srt::merge_partner(c0, hi != 0);
            if (hi) {
#pragma unroll
                for (int k = 0; k < 16; ++k) dl[(16 + k) * 32 + r32] = __builtin_bit_cast(unsigned, s1[k]) & 127u;
            } else {
#pragma unroll
                for (int k = 0; k < 16; ++k) dl[k * 32 + r32] = __builtin_bit_cast(unsigned, s0[k]) & 127u;
            }
            LDS_WAIT();
            if (hi) {
                float e[16]; float sum = 0.f;
#pragma unroll
                for (int k = 0; k < 16; ++k) { e[k] = __expf(c0[k] - c0[0]); sum += e[k]; }
                const float inv = 1.0f / sum; float* gp = EGATE + (size_t)t * 128 + h * 16;
#pragma unroll
                for (int k = 0; k < 4; ++k) *(f32x4*)(gp + 4 * k) = (f32x4){e[4 * k] * inv, e[4 * k + 1] * inv, e[4 * k + 2] * inv, e[4 * k + 3] * inv};
            } else {
                unsigned ex[16];
#pragma unroll
                for (int k = 0; k < 16; ++k) { const unsigned code = __builtin_bit_cast(unsigned, c0[k]) & 255u; ex[k] = dl[(code >> 4) * 32 + r32] * 128u + dl[(16 + (code & 15u)) * 32 + r32]; }
                int* ep = EIDX + (size_t)t * 128 + h * 16;
#pragma unroll
                for (int k = 0; k < 4; ++k) *(v4u*)(ep + 4 * k) = (v4u){ex[4 * k], ex[4 * k + 1], ex[4 * k + 2], ex[4 * k + 3]};
            }
            LDS_WAIT();
        }
    }
    SEAM(10);
    int my_slice = (int)(blockIdx.x & 7), my_rank = (int)(blockIdx.x >> 3);
    if (MK_LAUNCHES == 1 && (IN(11) || IN(13)) && (F.G & 7) == 0) {
        unsigned pre = 0;
        for (unsigned j = 0; j < 16; ++j) { const unsigned c = xb_ld(&bar.bar[XB_XCNT(j)]); if (j < bar.x) pre += c; }
        const int vid = (int)(pre + F.MISC[10]); my_slice = vid / (F.G >> 3); my_rank = vid % (F.G >> 3);
        if (my_slice > 7) { my_slice = (int)(blockIdx.x & 7); my_rank = (int)(blockIdx.x >> 3); }
    }
    my_slice = __builtin_amdgcn_readfirstlane(my_slice); my_rank = __builtin_amdgcn_readfirstlane(my_rank);
    const int NPER = F.G >> 3;
    if (IN(11)) {
        const int ptid = opaque_tid(), lane = ptid & 63, g = lane >> 3, c = lane & 7;
        const unsigned char* pus = PU + (size_t)my_slice * (16384 * 128); const unsigned lo16 = (unsigned)c * 16u; float* pa = PA_SLICE(my_slice);
        const int TPB = T / NPER, NTK = TPB / NWAVES; const int tb = my_rank * TPB + F.wave;
        const int col0 = my_slice * 128 + c * 16;
#define P9_H(HV, tt) do { HV[0] = *(const v4u*)(HQ + (size_t)(tt) * D + col0); } while (0)
#define P9_DO(R, HV, tt) do { const f32x2 r2_ = peer::idots(R, HV[0], c); *(f32x2*)(pa + (size_t)(tt) * 128 + g * 16 + 2 * c) = r2_; } while (0)
        LAS unsigned char* slot = F.lds + F.wave * 16384;
        v4u RA[16], RB[16]; v4u HE[2], HO[2], HC[2];
        const int tle = tb + 8 * (NTK - 2), tlo = tb + 8 * (NTK - 1);
        peer::Idx Ie = peer::load_idx(EIDX, tb, g), Io = peer::load_idx(EIDX, tb + 8, g);
        peer::load_rows(RA, Ie, pus, lo16); P9_H(HE, tb);
        peer::dma_rows(slot, Io, pus, lo16); P9_H(HO, tb + 8);
        Ie = peer::load_idx(EIDX, (tb + 16 < tle ? tb + 16 : tle), g);
#pragma unroll 1
        for (int k = 0; k < NTK; k += 2) {
            const int te = tb + 8 * k, to = te + 8; const int te2 = te + 16 < tle ? te + 16 : tle, to2 = to + 16 < tlo ? to + 16 : tlo, te4 = te + 32 < tle ? te + 32 : tle;
            P9_DO(RA, HE, te);
            Io = peer::load_idx(EIDX, to2, g);
            peer::load_rows(RA, Ie, pus, lo16); P9_H(HE, te2);
            asm volatile("s_waitcnt vmcnt(16)" ::: "memory");
            peer::read_slot(RB, slot, lane); HC[0] = HO[0];
            LDS_WAIT();
            peer::dma_rows(slot, Io, pus, lo16); P9_H(HO, to2); Ie = peer::load_idx(EIDX, te4, g);
            P9_DO(RB, HC, to);
        }
        VM_WAIT();
#undef P9_H
#undef P9_DO
    }
    SEAM(11);
    if (IN(12)) {
        const int ptid = opaque_tid();
        for (int i = F.vcu * (NWAVES * 64) + ptid; i < T * 128 / 4; i += F.G * NWAVES * 64) {
            f32x4 a = *((const f32x4*)PA_SLICE(0) + i);
#pragma unroll
            for (int sl = 1; sl < 8; ++sl) a += *((const f32x4*)PA_SLICE(sl) + i);
            const v4u e4 = *((const v4u*)EIDX + i); const f32x4 su = {SU[e4.x], SU[e4.y], SU[e4.z], SU[e4.w]}, sv = {SV[e4.x], SV[e4.y], SV[e4.z], SV[e4.w]}, gt4 = *((const f32x4*)EGATE + i); const float hs = HS[i >> 5];
            f32x4 o;
#pragma unroll
            for (int q = 0; q < 4; ++q) { const float x_ = a[q] * su[q] * hs; o[q] = 0.5f * x_ * (1.f + erff(x_ * 0.70710678118654752f)) * gt4[q] * sv[q]; }
            *((v2u*)COEF + i) = (v2u){pk2(o[0], o[1]), pk2(o[2], o[3])};
        }
    }
    SEAM(12);
    if (IN(13)) {
        const int ptid = opaque_tid(), lane = ptid & 63, g = lane >> 3, c = lane & 7;
        const unsigned char* pvs = PV + (size_t)my_slice * (16384 * 128); const unsigned lo16 = (unsigned)c * 16u;
        const int TPB = T / NPER, NTK = TPB / NWAVES; const int tb = my_rank * TPB + F.wave; const int bb = (my_rank * TPB) / S;
        const int col = my_slice * 128 + c * 16 + 2 * g;
        const f32x2 gt2 = *(const f32x2*)(MOD + bb * 6 * D + 5 * D + col);
#define P11_C(CV, XO, tt) do { const v4u* cp_ = (const v4u*)((const bf16*)COEF + (size_t)(tt) * 128 + g * 16); CV[0] = cp_[0]; CV[1] = cp_[1]; { const f32x2 xx_ = *(const f32x2*)(Xin + (size_t)(tt) * D + col); const unsigned yy_ = *(const unsigned*)(YB + (size_t)(tt) * D + col); XO = (f32x2){xx_[0] + bflo(yy_), xx_[1] + bfhi(yy_)}; } } while (0)
#define P11_DO(R, CV, XO, tt) do { const f32x2 w_ = peer::axpys(R, CV[0], CV[1], g); const f32x2 xn_ = {XO[0] + gt2[0] * w_[0], XO[1] + gt2[1] * w_[1]}; \
            if (!args.dry) *(f32x2*)(X1 + (size_t)(tt) * D + col) = xn_; } while (0)
        LAS unsigned char* slot = F.lds + F.wave * 16384;
        v4u R[16]; v4u CA[2], CN[2]; f32x2 OA, ON;
        const int tl = tb + 8 * (NTK - 1);
        peer::Idx I = peer::load_idx(EIDX, tb, g);
        peer::dma_rows(slot, I, pvs, lo16); P11_C(CN, ON, tb); I = peer::load_idx(EIDX, tb + 8 < tl ? tb + 8 : tl, g);
#pragma unroll 1
        for (int k = 0; k < NTK; ++k) {
            const int t0 = tb + 8 * k; const int t1 = t0 + 8 < tl ? t0 + 8 : tl, t2 = t0 + 16 < tl ? t0 + 16 : tl;
            VM_WAIT();
            peer::read_slot(R, slot, lane); CA[0] = CN[0]; CA[1] = CN[1]; OA = ON;
            LDS_WAIT();
            peer::dma_rows(slot, I, pvs, lo16); P11_C(CN, ON, t1); I = peer::load_idx(EIDX, t2, g);
            P11_DO(R, CA, OA, t0);
        }
        VM_WAIT();
#undef P11_C
#undef P11_DO
    }
    SEAM(13);
    if (IN(14)) {
        const int ptid = opaque_tid(), lane = ptid & 63;
        for (int m = gw; m < T; m += NGW) {
            f32x4* xr = (f32x4*)(OUTp + (size_t)m * D) + lane; f32x4 v[4]; float ss = 0.f;
#pragma unroll
            for (int j = 0; j < 4; ++j) { v[j] = xr[64 * j]; ss += v[j][0] * v[j][0] + v[j][1] * v[j][1] + v[j][2] * v[j][2] + v[j][3] * v[j][3]; }
            const float rr = 1.0f / sqrtf(wave_sum(ss) * (1.f / D) + EPS);
            if (!args.dry)
#pragma unroll
            for (int j = 0; j < 4; ++j) { const f32x4 gg = *((const f32x4*)g_final + lane + 64 * j); xr[64 * j] = v[j] * rr * gg; }
        }
    }
#undef IN
#undef SEAM
#undef gt
}

extern "C" void kernel_launch(void* const* d_in, const int* in_sizes, int n_in, void* d_out, int out_size, void* d_ws, size_t ws_size, hipStream_t stream) {
    static int grid = 0;
    if (grid == 0) {
        int dev = 0, cus = 0, per_cu = 0;
        if (n_in != 19 || out_size != T * D || ws_size < WS_END) { fprintf(stderr, "kernel_launch: unexpected shapes (n_in %d out %d ws %zu)\n", n_in, out_size, ws_size); grid = -1; return; }
        if (hipGetDevice(&dev) != hipSuccess || hipDeviceGetAttribute(&cus, hipDeviceAttributeMultiprocessorCount, dev) != hipSuccess) { grid = -1; return; }
        if (hipFuncSetAttribute((const void*)mk_fwd, hipFuncAttributeMaxDynamicSharedMemorySize, LDS_BYTES) != hipSuccess) { fprintf(stderr, "kernel_launch: hipFuncSetAttribute failed\n"); grid = -1; return; }
        if (hipOccupancyMaxActiveBlocksPerMultiprocessor(&per_cu, (const void*)mk_fwd, NWAVES * 64, LDS_BYTES) != hipSuccess || per_cu < 1) { fprintf(stderr, "kernel_launch: occupancy query says %d blocks per CU\n", per_cu); per_cu = 1; }
        (void)hipGetLastError();
        grid = cus;
        if (grid > 256) grid = 256;
    }
    if (grid < 0) return;
    if (hipMemsetAsync((char*)d_ws + WS_CTL, 0, CTL_ZERO_BYTES, stream) != hipSuccess) return;
    Args a{};
    for (int i = 0; i < 19; ++i) a.in[i] = d_in[i];
    a.out = (float*)d_out; a.ws = (unsigned char*)d_ws;
    if (MK_LAUNCHES == 1) { a.ph_lo = 0; a.ph_hi = NPHASE; hipLaunchKernelGGL(mk_fwd, dim3(grid), dim3(NWAVES * 64), LDS_BYTES, stream, a); }
    else for (int p = 0; p < NPHASE; ++p) { a.ph_lo = p; a.ph_hi = p + 1;
#ifdef REP_PHASE
        if (p == REP_PHASE) { a.dry = 1; hipLaunchKernelGGL(mk_fwd, dim3(grid), dim3(NWAVES * 64), LDS_BYTES, stream, a); a.dry = 0; }
#endif
        hipLaunchKernelGGL(mk_fwd, dim3(grid), dim3(NWAVES * 64), LDS_BYTES, stream, a); }
}
```

```cpp
#include <hip/hip_runtime.h>
#include <cstdio>
#include <cstdint>
#include <math.h>

namespace pg8 {
#define PG8_LAS __attribute__((address_space(3)))
typedef unsigned short bf16_t;
typedef short bf16x8 __attribute__((ext_vector_type(8)));
typedef float f32x4 __attribute__((ext_vector_type(4)));
typedef unsigned u32x4 __attribute__((ext_vector_type(4)));
constexpr int BM = 256, BK = 64, HALF = 128, HTB = HALF * BK * 2  , STAGE_BYTES = 8 * HTB, NXCD = 8, WGM = 8;

__host__ __device__ __forceinline__ int lds_byte(int r, int c) { const int st = (r >> 4) * 2 + (c >> 5), rr = r & 15, cc = c & 31, ob = rr * 64 + cc * 2; return st * 1024 + (ob ^ (((ob >> 9) & 1) << 5)); }
__host__ __device__ __forceinline__ void stage_rc(int b, int& R, int& C) { const int st = b / 1024, sb = b % 1024, swz = sb ^ (((sb >> 9) & 1) << 5); R = (st >> 1) * 16 + swz / 64; C = (st & 1) * 32 + (swz % 64) / 2; }
__host__ __device__ __forceinline__ int perm32(int rho) { const int n = rho >> 4, i = rho & 15; return 8 * (i >> 2) + 4 * n + (i & 3); }

struct Unit { int pm, pn; };
struct Gemm { const bf16_t* A; const bf16_t* Bt; int M, N, K, lda; };

struct StaticOrder {
    int nM, nN, nwg, G, c;
    __host__ __device__ void init(int M, int N, int G_, int c_) { nM = M / BM; nN = N / BM; nwg = nM * nN; G = G_; c = c_; }
    __host__ __device__ bool next(int i, Unit& u) const {
        const long L = (long)i * G + c; if (L >= nwg) return false;
        int wgid = (int)L; { const int q = nwg / NXCD, r = nwg % NXCD, xcd = wgid % NXCD, off = wgid / NXCD; wgid = (xcd < r ? xcd * (q + 1) : r * (q + 1) + (xcd - r) * q) + off; }
        const int nig = WGM * nN, gid = wgid / nig, fm = gid * WGM, gsz = (nM - fm) < WGM ? (nM - fm) : WGM;
        u.pm = fm + ((wgid % nig) % gsz); u.pn = (wgid % nig) / gsz; return true;
    }
    __device__ __forceinline__ void a_ready(const Unit&) const {}
    __device__ __forceinline__ void done(const Unit&) const {}
};
template <class Epi, class Sched, bool ALIGN_EPI = false, bool SP2 = false>
__device__ __forceinline__ void gemm_phase(PG8_LAS unsigned char* lds, const Gemm g, const Sched& S, const Epi& E) {
    const int tid = threadIdx.x, wid = __builtin_amdgcn_readfirstlane(tid >> 6), lane = tid & 63, wr = wid >> 2, wc = wid & 3, fr = lane & 15, fq = lane >> 4;
    const int K = g.K, nt = K / BK;
    unsigned voffA[2], voffB[2];
#pragma unroll
    for (int i = 0; i < 2; ++i) { int R, C; stage_rc(tid * 16 + i * 8192, R, C); const int Rb = Epi::PERM ? ((R & ~31) + perm32(R & 31)) : R;
        voffA[i] = (unsigned)(R * g.lda + C) * 2u; voffB[i] = (unsigned)(Rb * K + C) * 2u; }
    const size_t kstep = (size_t)(BK * 2);
    const size_t hsB = (size_t)HALF * K * 2, hsA = (size_t)HALF * g.lda * 2;
    const size_t tsB = 2 * hsB, tsA = 2 * hsA;
    const unsigned ldsw = (unsigned)wid * 1024u;
    const int aoff = lds_byte(wr * 64 + fr, fq * 8), boff = lds_byte(wc * 32 + fr, fq * 8);
#define PG8_SA(b, h) (((b) * 2 + (h)) * HTB)
#define PG8_SB(b, h) ((4 + (b) * 2 + (h)) * HTB)
#define PG8_STAGE(bufoff, gbase, voff) do { _Pragma("unroll") for (int _i = 0; _i < 2; ++_i) \
        __builtin_amdgcn_global_load_lds((const unsigned*)((const char*)(gbase) + (voff)[_i]), (PG8_LAS unsigned*)(lds + (bufoff) + ldsw + _i * 8192), 16, 0, 0); } while (0)
#define PG8_LDA(dst, b, h) do { _Pragma("unroll") for (int m = 0; m < 4; ++m) _Pragma("unroll") for (int k = 0; k < 2; ++k) dst[m][k] = *(const PG8_LAS bf16x8*)(lds + PG8_SA(b, h) + aoff + m * 2048 + k * 1024); } while (0)
#define PG8_LDB(dst, b, h) do { _Pragma("unroll") for (int n = 0; n < 2; ++n) _Pragma("unroll") for (int k = 0; k < 2; ++k) dst[n][k] = *(const PG8_LAS bf16x8*)(lds + PG8_SB(b, h) + boff + n * 2048 + k * 1024); } while (0)
#define PG8_MMA(ai, bj, At, Bt) do { __builtin_amdgcn_s_setprio(1); _Pragma("unroll") for (int m = 0; m < 4; ++m) _Pragma("unroll") for (int n = 0; n < 2; ++n) _Pragma("unroll") for (int k = 0; k < 2; ++k) \
        acc[ai][bj][m][n] = __builtin_amdgcn_mfma_f32_16x16x32_bf16(Bt[n][k], At[m][k], acc[ai][bj][m][n], 0, 0, 0); __builtin_amdgcn_s_setprio(0); } while (0)
#define PG8_WAIT_V(n) asm volatile("s_waitcnt vmcnt(" #n ")" ::: "memory")
#define PG8_WAIT_L(n) asm volatile("s_waitcnt lgkmcnt(" #n ")" ::: "memory")
#define PG8_BAR __builtin_amdgcn_s_barrier()
#define PG8_SCHED __builtin_amdgcn_sched_barrier(0)
    Unit cur, nxt; int ui = 0;
    if (!S.next(0, cur)) return;
    f32x4 acc[2][2][4][2];
#pragma unroll
    for (int a = 0; a < 2; ++a)
#pragma unroll
        for (int b = 0; b < 2; ++b)
#pragma unroll
            for (int m = 0; m < 4; ++m)
#pragma unroll
                for (int n = 0; n < 2; ++n) acc[a][b][m][n] = (f32x4){0.f, 0.f, 0.f, 0.f};
    bf16x8 At[4][2], B0[2][2], B1[2][2];
    const char* cA = (const char*)g.A + (size_t)cur.pm * tsA; const char* cB = (const char*)g.Bt + (size_t)cur.pn * tsB;
    S.a_ready(cur);
    if constexpr (SP2) {
        PG8_STAGE(PG8_SB(0, 0), cB, voffB); PG8_STAGE(PG8_SB(0, 1), cB + hsB, voffB); PG8_STAGE(PG8_SA(0, 0), cA, voffA); PG8_STAGE(PG8_SA(0, 1), cA + hsA, voffA);
        if (wr == 1) PG8_BAR;
        PG8_WAIT_V(2); PG8_BAR;
        PG8_STAGE(PG8_SB(1, 0), cB + kstep, voffB); PG8_STAGE(PG8_SA(1, 0), cA + kstep, voffA); PG8_STAGE(PG8_SB(1, 1), cB + hsB + kstep, voffB);
        PG8_WAIT_V(6); PG8_BAR;
    } else {
        PG8_STAGE(PG8_SB(0, 0), cB, voffB); PG8_STAGE(PG8_SA(0, 0), cA, voffA); PG8_STAGE(PG8_SB(0, 1), cB + hsB, voffB); PG8_STAGE(PG8_SA(0, 1), cA + hsA, voffA);
        if (wr == 1) PG8_BAR;
        PG8_WAIT_V(4); PG8_BAR;
        PG8_STAGE(PG8_SB(1, 0), cB + kstep, voffB); PG8_STAGE(PG8_SA(1, 0), cA + kstep, voffA); PG8_STAGE(PG8_SB(1, 1), cB + hsB + kstep, voffB);
        PG8_WAIT_V(6); PG8_BAR;
    }
    for (;;) {
        const bool has_next = S.next(ui + 1, nxt);
        const char* nA = has_next ? (const char*)g.A + (size_t)nxt.pm * tsA : cA; const char* nB = has_next ? (const char*)g.Bt + (size_t)nxt.pn * tsB : cB;
        for (int t = 0; t < nt; t += 2) {
            const bool last = (t == nt - 2);
            const char* a1 = cA + (size_t)(t + 1) * kstep;
            const char* a2 = last ? nA : cA + (size_t)(t + 2) * kstep; const char* b2 = last ? nB : cB + (size_t)(t + 2) * kstep;
            const char* a3 = a2 + kstep; const char* b3 = b2 + kstep;
            if (last && has_next) S.a_ready(nxt);
            if constexpr (SP2) {
            PG8_LDB(B0, 0, 0); PG8_LDB(B1, 0, 1); PG8_SCHED; PG8_LDA(At, 0, 0); PG8_STAGE(PG8_SA(1, 1), a1 + hsA, voffA);
            PG8_WAIT_V(8); PG8_WAIT_L(0); PG8_BAR; PG8_MMA(0, 0, At, B0); PG8_MMA(0, 1, At, B1); PG8_BAR; PG8_SCHED;
            PG8_LDA(At, 0, 1); PG8_STAGE(PG8_SB(0, 0), b2, voffB); PG8_STAGE(PG8_SB(0, 1), b2 + hsB, voffB); PG8_STAGE(PG8_SA(0, 0), a2, voffA);
            PG8_WAIT_V(8); PG8_WAIT_L(0); PG8_BAR; PG8_MMA(1, 0, At, B0); PG8_MMA(1, 1, At, B1); PG8_BAR; PG8_SCHED;
            PG8_LDB(B0, 1, 0); PG8_LDB(B1, 1, 1); PG8_SCHED; PG8_LDA(At, 1, 0); PG8_STAGE(PG8_SA(0, 1), a2 + hsA, voffA);
            PG8_WAIT_V(8); PG8_WAIT_L(0); PG8_BAR; PG8_MMA(0, 0, At, B0); PG8_MMA(0, 1, At, B1); PG8_BAR; PG8_SCHED;
            PG8_LDA(At, 1, 1); PG8_STAGE(PG8_SB(1, 0), b3, voffB); PG8_STAGE(PG8_SB(1, 1), b3 + hsB, voffB); PG8_STAGE(PG8_SA(1, 0), a3, voffA);
            PG8_WAIT_V(8); PG8_WAIT_L(0); PG8_BAR; PG8_MMA(1, 0, At, B0); PG8_MMA(1, 1, At, B1); PG8_BAR; PG8_SCHED;
            } else {
            PG8_LDB(B0, 0, 0); PG8_SCHED; PG8_LDA(At, 0, 0); PG8_STAGE(PG8_SA(1, 1), a1 + hsA, voffA);
            PG8_WAIT_L(8); PG8_BAR; PG8_WAIT_L(0); PG8_MMA(0, 0, At, B0); PG8_BAR; PG8_SCHED;
            PG8_LDB(B1, 0, 1); PG8_STAGE(PG8_SB(0, 0), b2, voffB);
            PG8_BAR; PG8_WAIT_L(0); PG8_MMA(0, 1, At, B1); PG8_BAR;
            PG8_LDA(At, 0, 1); PG8_STAGE(PG8_SA(0, 0), a2, voffA);
            PG8_BAR; PG8_WAIT_L(0); PG8_MMA(1, 0, At, B0); PG8_BAR; PG8_SCHED;
            PG8_STAGE(PG8_SB(0, 1), b2 + hsB, voffB);
            PG8_WAIT_V(6); PG8_BAR; PG8_MMA(1, 1, At, B1); PG8_BAR;
            PG8_LDB(B0, 1, 0); PG8_SCHED; PG8_LDA(At, 1, 0); PG8_STAGE(PG8_SA(0, 1), a2 + hsA, voffA);
            PG8_WAIT_L(8); PG8_BAR; PG8_WAIT_L(0); PG8_MMA(0, 0, At, B0); PG8_BAR; PG8_SCHED;
            PG8_LDB(B1, 1, 1); PG8_STAGE(PG8_SB(1, 0), b3, voffB);
            PG8_BAR; PG8_WAIT_L(0); PG8_MMA(0, 1, At, B1); PG8_BAR;
            PG8_LDA(At, 1, 1); PG8_STAGE(PG8_SA(1, 0), a3, voffA);
            PG8_BAR; PG8_WAIT_L(0); PG8_MMA(1, 0, At, B0); PG8_BAR; PG8_SCHED;
            PG8_STAGE(PG8_SB(1, 1), b3 + hsB, voffB);
            PG8_WAIT_V(6); PG8_BAR; PG8_MMA(1, 1, At, B1); PG8_BAR;
            }
        }
        if constexpr (ALIGN_EPI) { if (wr == 0) PG8_BAR; }
        if constexpr (!Epi::AFTER_DRAIN) { E(acc, cur, wr, wc, fr, fq); S.done(cur); }
        if (!has_next) break;
#pragma unroll
        for (int a = 0; a < 2; ++a)
#pragma unroll
            for (int b = 0; b < 2; ++b)
#pragma unroll
                for (int m = 0; m < 4; ++m)
#pragma unroll
                    for (int n = 0; n < 2; ++n) acc[a][b][m][n] = (f32x4){0.f, 0.f, 0.f, 0.f};
        cur = nxt; cA = nA; cB = nB; ++ui;
        if constexpr (ALIGN_EPI) { if (wr == 1) PG8_BAR; }
    }
    PG8_WAIT_V(0);
    if constexpr (!ALIGN_EPI) { if (wr == 0) PG8_BAR; }
    PG8_BAR;
    if constexpr (Epi::AFTER_DRAIN) { E.fused(acc, cur, wr, wc, fr, fq, lds, wid, lane); S.done(cur); }
#undef PG8_SA
#undef PG8_SB
#undef PG8_STAGE
#undef PG8_LDA
#undef PG8_LDB
#undef PG8_MMA
#undef PG8_WAIT_V
#undef PG8_WAIT_L
#undef PG8_BAR
#undef PG8_SCHED
}
}


constexpr int NWAVES = 8;
constexpr int NB = 4, S = 4096, D = 1024, T = NB * S;
constexpr int NZ = 2816;
constexpr float EPS = 1e-6f;
constexpr float LOG2E = 1.4426950408889634f;
constexpr float QS_MLA = 0.10206207261596575f * LOG2E;
constexpr float QS_MOBA = 0.125f * LOG2E;
#ifndef MK_LAUNCHES
#define MK_LAUNCHES 1

#endif
constexpr int NPHASE = 15;

constexpr size_t MiB = 1u << 20;
constexpr size_t WS_CTL = 0, CTL_ZERO_BYTES = 1 * MiB;
constexpr int CW_BAR = 4096;
constexpr size_t OFF_SSQ_Q = 256 * 1024, OFF_SSQ_KV = 320 * 1024, OFF_SSQ_1 = 384 * 1024;
constexpr size_t WS_W_IN = 1 * MiB, WS_W_UQ = 7 * MiB, WS_W_UKV = 8 * MiB + 512 * 1024, WS_W_OUT = 9 * MiB, WS_W_PQ = 11 * MiB;
constexpr size_t WS_PU = 13 * MiB, WS_PV = 29 * MiB;
constexpr size_t WS_SU = 253 * MiB, WS_SV = 253 * MiB + 64 * 1024;
constexpr size_t WS_HB = 77 * MiB;
constexpr size_t WS_CQ = 109 * MiB, WS_CKV = 133 * MiB, WS_KRF = 141 * MiB, WS_KRB = 143 * MiB, WS_MQ = 144 * MiB, WS_MK = 160 * MiB, WS_MV = 176 * MiB;
constexpr size_t WS_QM = 192 * MiB, WS_KN = 216 * MiB, WS_VM = 232 * MiB;
constexpr size_t WS_ROPE = 248 * MiB;
constexpr size_t WS_MOD = 250 * MiB;
constexpr size_t WS_KMEAN = 251 * MiB;
constexpr size_t WS_KH = 252 * MiB, WS_KL = 252 * MiB + 512 * 1024;
constexpr size_t WS_PQ = 109 * MiB;
constexpr size_t WS_EIDX = 173 * MiB, WS_EGATE = 181 * MiB;
constexpr size_t WS_HQ = 189 * MiB;
constexpr size_t WS_HS = 253 * MiB + 128 * 1024;
constexpr size_t WS_PA_HI = 189 * MiB;
constexpr size_t WS_COEF = 221 * MiB, WS_ESU = 229 * MiB, WS_ESV = 237 * MiB;
constexpr size_t OFF_SSQ_2 = 448 * 1024;
constexpr size_t OFF_KSUM = 512 * 1024;
constexpr int CW_QCTR2 = 8200, CW_CNT = 8448, CW_MODFLAG = 8264;
constexpr int QR0A = 0, QR0B = 14, QR2 = 21, QR3 = 8;
constexpr int QROW2 = 96 * 8 * QR0A + 160 * 8 * QR0B, QROW3 = QROW2 + 512 * QR2;
static_assert(QROW3 + 512 * QR3 == 32768, "table rows");
constexpr int LIST_CAP = 3840;
constexpr size_t WS_LIST = 109 * MiB;
constexpr size_t WS_SELM = 253 * MiB + 256 * 1024;
constexpr size_t WS_QP = 254 * MiB;
constexpr size_t PO_OFF = 0, PML_OFF = 48 * MiB;
constexpr size_t WS_END = 256 * MiB;

constexpr int RING_BYTES = 131072;
constexpr int LDSCTL_OFF = RING_BYTES, MISC_OFF = LDSCTL_OFF + 320;
constexpr int LDS_BYTES = 147456;

#define GAS __attribute__((address_space(1)))
#define LAS __attribute__((address_space(3)))
typedef unsigned short bf16;
typedef unsigned v4u __attribute__((ext_vector_type(4)));
typedef unsigned v2u __attribute__((ext_vector_type(2)));
typedef float f32x4 __attribute__((ext_vector_type(4)));
typedef float f32x2 __attribute__((ext_vector_type(2)));
typedef float f32x16 __attribute__((ext_vector_type(16)));
typedef short bf16x8 __attribute__((ext_vector_type(8)));
typedef short s16x4 __attribute__((ext_vector_type(4)));
typedef __bf16 bf16x2_t __attribute__((ext_vector_type(2)));
typedef GAS unsigned gu32;
#define LDS_WAIT() asm volatile("s_waitcnt lgkmcnt(0)" ::: "memory")
#define VM_WAIT() asm volatile("s_waitcnt vmcnt(0)" ::: "memory")
__device__ __forceinline__ unsigned f2bf(float f) { unsigned u = __builtin_bit_cast(unsigned, f); return (u + 0x7fffu + ((u >> 16) & 1u)) >> 16; }
__device__ __forceinline__ unsigned pk2(float lo, float hi) { f32x2 v = {lo, hi}; bf16x2_t b = __builtin_convertvector(v, bf16x2_t); return __builtin_bit_cast(unsigned, b); }
__device__ __forceinline__ float bflo(unsigned w) { return __builtin_bit_cast(float, w << 16); }
__device__ __forceinline__ float bfhi(unsigned w) { return __builtin_bit_cast(float, w & 0xffff0000u); }
__device__ __forceinline__ float dot2_bf16(unsigned w, unsigned x, float acc) { return __builtin_amdgcn_fdot2_f32_bf16(__builtin_bit_cast(bf16x2_t, w), __builtin_bit_cast(bf16x2_t, x), acc, false); }
__device__ __forceinline__ int opaque_tid() { int t = threadIdx.x; asm volatile("" : "+v"(t)); return t; }
template <int CTRL> __device__ __forceinline__ float dpp_f(float v) { return __builtin_bit_cast(float, __builtin_amdgcn_update_dpp(0, __builtin_bit_cast(int, v), CTRL, 0xf, 0xf, true)); }
__device__ __forceinline__ float lane_xor16(float v) { const auto r = __builtin_amdgcn_permlane16_swap(__builtin_bit_cast(unsigned, v), __builtin_bit_cast(unsigned, v), false, false); return __builtin_bit_cast(float, (threadIdx.x & 16) ? r[0] : r[1]); }
__device__ __forceinline__ float lane_xor32(float v) { const auto r = __builtin_amdgcn_permlane32_swap(__builtin_bit_cast(unsigned, v), __builtin_bit_cast(unsigned, v), false, false); return __builtin_bit_cast(float, (threadIdx.x & 32) ? r[0] : r[1]); }
__device__ __forceinline__ float wave_sum(float v) {
    v += dpp_f<0xB1>(v); v += dpp_f<0x4E>(v); v += dpp_f<0x141>(v); v += dpp_f<0x140>(v);
    v += lane_xor16(v); v += lane_xor32(v);
    return v;
}
__device__ __forceinline__ float wave_max(float v) {
    v = fmaxf(v, dpp_f<0xB1>(v)); v = fmaxf(v, dpp_f<0x4E>(v)); v = fmaxf(v, dpp_f<0x141>(v)); v = fmaxf(v, dpp_f<0x140>(v));
    v = fmaxf(v, lane_xor16(v)); v = fmaxf(v, lane_xor32(v));
    return v;
}

#define XB_TMO      128
#define XB_XCNT(j)  (256  + 64 * (j))
#define XB_XSUB(j)  (1280 + 64 * (j))
#define XB_XGEN(j)  (2304 + 64 * (j))
#define XB_TOP      3328
#define XB_TOPGEN   3392
#define XCD_BAR_WORDS 3456
#define XB_SPIN_CAP (1u << 18)

__device__ __forceinline__ unsigned xb_ld(unsigned* p)              { return __hip_atomic_load(p, __ATOMIC_RELAXED, __HIP_MEMORY_SCOPE_AGENT); }
__device__ __forceinline__ unsigned xb_add(unsigned* p, unsigned v) { return __hip_atomic_fetch_add(p, v, __ATOMIC_RELAXED, __HIP_MEMORY_SCOPE_AGENT); }
__device__ __forceinline__ unsigned xb_xcc_id() { return (unsigned)__builtin_amdgcn_s_getreg((3 << 11) | 20) & 0xFu; }
#define XB_SPIN(cond, bar) do { unsigned _sp = 0; while (cond) { __builtin_amdgcn_s_sleep(1); \
    if ((++_sp & 255u) == 0u) { if (xb_ld(&(bar)[XB_TMO])) break; if (_sp > XB_SPIN_CAP) { atomicAdd(&(bar)[XB_TMO], 1u); break; } } } } while (0)

struct XcdBarrier {
    unsigned* bar; unsigned x;
    volatile LAS unsigned* st;
};

__device__ __forceinline__ XcdBarrier xcd_barrier_post(unsigned* bar, volatile LAS unsigned* st) {
    XcdBarrier b; b.bar = bar; b.x = xb_xcc_id(); b.st = st;
    if (threadIdx.x == 0) st[2] = xb_add(&bar[XB_XCNT(b.x)], 1u);
    return b;
}
__device__ __forceinline__ void xcd_barrier_complete(unsigned* bar, unsigned x, unsigned& nloc, unsigned& nx) {
    const unsigned G = gridDim.x * gridDim.y * gridDim.z;
    unsigned sum, cnt, mine, sp = 0u;
    for (;;) {
        sum = 0u; cnt = 0u; mine = 0u;
#pragma unroll
        for (unsigned j = 0; j < 16; ++j) { const unsigned c = xb_ld(&bar[XB_XCNT(j)]); sum += c; cnt += (c > 0u) ? 1u : 0u; mine = (j == x) ? c : mine; }
        if (sum == G) break;
        __builtin_amdgcn_s_sleep(1);
        if ((++sp & 255u) == 0u) { if (xb_ld(&bar[XB_TMO])) break; if (sp > XB_SPIN_CAP) { atomicAdd(&bar[XB_TMO], 1u); break; } }
    }
    nloc = mine > 0u ? mine : 1u; nx = cnt > 0u ? cnt : 1u;
}

__device__ __forceinline__ void xcd_barrier(const XcdBarrier& b) {
    asm volatile("s_waitcnt vmcnt(0)" ::: "memory");
    __syncthreads();
    if (threadIdx.x == 0) {
        unsigned* bar = b.bar;
        __builtin_amdgcn_s_waitcnt(0);
        unsigned nloc = b.st[0], nx = b.st[1];
        if (nloc == 0u) { xcd_barrier_complete(bar, b.x, nloc, nx); b.st[0] = nloc; b.st[1] = nx; }
        const unsigned old = xb_add(&bar[XB_XSUB(b.x)], 1u);
        const unsigned gen = old / nloc;
        if (old + 1u == (gen + 1u) * nloc) {
            __builtin_amdgcn_fence(__ATOMIC_RELEASE, "agent");
            asm volatile("s_waitcnt vmcnt(0)" ::: "memory");
            (void)__hip_atomic_fetch_add(&bar[XB_TOP], 1u, __ATOMIC_RELAXED, __HIP_MEMORY_SCOPE_AGENT);
        }
        XB_SPIN(xb_ld(&bar[XB_TOP]) < (gen + 1u) * nx, bar);
        __builtin_amdgcn_fence(__ATOMIC_ACQUIRE, "agent");
        asm volatile("s_waitcnt vmcnt(0)" ::: "memory");
    }
    __syncthreads();
}


namespace epi {
using pg8::Unit; using pg8::f32x4; using pg8::bf16_t;
__device__ __forceinline__ v4u pack8(const f32x4& a, const f32x4& b, float s) { v4u w; w.x = pk2(a[0] * s, a[1] * s); w.y = pk2(a[2] * s, a[3] * s); w.z = pk2(b[0] * s, b[1] * s); w.w = pk2(b[2] * s, b[3] * s); return w; }
__device__ __forceinline__ float sq8(const f32x4& a, const f32x4& b) { return a[0] * a[0] + a[1] * a[1] + a[2] * a[2] + a[3] * a[3] + b[0] * b[0] + b[1] * b[1] + b[2] * b[2] + b[3] * b[3]; }

struct EpiZ {
    static constexpr bool PERM = true, AFTER_DRAIN = false;
    unsigned char* ws; int dry;
    __device__ __forceinline__ void operator()(const f32x4 (&acc)[2][2][4][2], const Unit& u, int wr, int wc, int fr_in, int fq_in) const {
        bf16_t* const cq = (bf16_t*)(ws + WS_CQ); bf16_t* const ckv = (bf16_t*)(ws + WS_CKV); bf16_t* const mq = (bf16_t*)(ws + WS_MQ); bf16_t* const mk = (bf16_t*)(ws + WS_MK); bf16_t* const mv = (bf16_t*)(ws + WS_MV);
        float* const krf = (float*)(ws + WS_KRF); float* const ssq_q = (float*)(ws + OFF_SSQ_Q); float* const ssq_kv = (float*)(ws + OFF_SSQ_KV);
        int t_ = threadIdx.x; asm volatile("" : "+v"(t_)); const int fr = t_ & 15, fq = (t_ >> 4) & 3;
        const int pn = u.pn;
        if (pn == 10) {
            if (wc == 0) {
#pragma unroll
                for (int ai = 0; ai < 2; ++ai)
#pragma unroll
                    for (int m = 0; m < 4; ++m) { const int row = u.pm * 256 + ai * 128 + wr * 64 + m * 16 + fr; float* p = krf + (size_t)row * 32 + 8 * fq;
                        *(f32x4*)p = acc[ai][0][m][0]; *(f32x4*)(p + 4) = acc[ai][0][m][1]; }
            }
            return;
        }
        bf16_t* base; int ld, cb; float* ssq = nullptr;
        if (pn < 3) { base = cq; ld = 768; cb = pn * 256; ssq = ssq_q; } else if (pn == 3) { base = ckv; ld = 256; cb = 0; ssq = ssq_kv; }
        else if (pn < 6) { base = mq; ld = 512; cb = (pn - 4) * 256; } else if (pn < 8) { base = mk; ld = 512; cb = (pn - 6) * 256; } else { base = mv; ld = 512; cb = (pn - 8) * 256; }
#pragma unroll
        for (int ai = 0; ai < 2; ++ai)
#pragma unroll
            for (int m = 0; m < 4; ++m) { const int row = u.pm * 256 + ai * 128 + wr * 64 + m * 16 + fr; float ss = 0.f;
#pragma unroll
                for (int bj = 0; bj < 2; ++bj) { const int col = cb + bj * 128 + wc * 32 + 8 * fq;
                    *(v4u*)(base + (size_t)row * ld + col) = pack8(acc[ai][bj][m][0], acc[ai][bj][m][1], 1.f); ss += sq8(acc[ai][bj][m][0], acc[ai][bj][m][1]); }
                if (pn <= 3) { ss += lane_xor16(ss); ss += lane_xor32(ss); if (fq == 0 && !dry) atomicAdd(ssq + row, ss); } }
        if (pn == 6 || pn == 7) {
            float* const ksum = (float*)(ws + OFF_KSUM); const int bb = u.pm >> 4, nn = u.pm & 15;
#pragma unroll
            for (int bj = 0; bj < 2; ++bj) { f32x4 s0 = acc[0][bj][0][0], s1 = acc[0][bj][0][1];
#pragma unroll
                for (int ai = 0; ai < 2; ++ai)
#pragma unroll
                    for (int m = 0; m < 4; ++m) if (ai | m) { s0 += acc[ai][bj][m][0]; s1 += acc[ai][bj][m][1]; }
                const int colmk = (pn - 6) * 256 + bj * 128 + wc * 32 + 8 * fq; float* kp = ksum + ((size_t)(bb * 8 + (colmk >> 6)) * 16 + nn) * 64 + (colmk & 63);
#pragma unroll
                for (int j = 0; j < 8; ++j) { float v = (j < 4) ? s0[j & 3] : s1[j & 3]; v += dpp_f<0xB1>(v); v += dpp_f<0x4E>(v); v += dpp_f<0x141>(v); v += dpp_f<0x140>(v); if (fr == 0 && !dry) atomicAdd(kp + j, v); } }
        }
    }
};
struct EpiQ {
    static constexpr bool PERM = true, AFTER_DRAIN = false;
    unsigned char* ws;
    __device__ __forceinline__ void operator()(const f32x4 (&acc)[2][2][4][2], const Unit& u, int wr, int wc, int fr_in, int fq_in) const {
        bf16_t* const qm = (bf16_t*)(ws + WS_QM); const float* const ssq_q = (const float*)(ws + OFF_SSQ_Q);
        int t_ = threadIdx.x; asm volatile("" : "+v"(t_)); const int fr = t_ & 15, fq = (t_ >> 4) & 3;
        float sqv[2][4];
#pragma unroll
        for (int ai = 0; ai < 2; ++ai)
#pragma unroll
            for (int m = 0; m < 4; ++m) sqv[ai][m] = ssq_q[u.pm * 256 + ai * 128 + wr * 64 + m * 16 + fr];
#pragma unroll
        for (int ai = 0; ai < 2; ++ai)
#pragma unroll
            for (int m = 0; m < 4; ++m) { const int row = u.pm * 256 + ai * 128 + wr * 64 + m * 16 + fr; const float rs = QS_MLA / sqrtf(sqv[ai][m] * (1.0f / 768.0f) + EPS);
#pragma unroll
                for (int bj = 0; bj < 2; ++bj) { const int col = u.pn * 256 + bj * 128 + wc * 32 + 8 * fq;
                    *(v4u*)(qm + (size_t)row * 768 + col) = pack8(acc[ai][bj][m][0], acc[ai][bj][m][1], rs); } }
    }
};
struct EpiKV {
    static constexpr bool PERM = true, AFTER_DRAIN = false;
    unsigned char* ws;
    __device__ __forceinline__ void operator()(const f32x4 (&acc)[2][2][4][2], const Unit& u, int wr, int wc, int fr_in, int fq_in) const {
        bf16_t* const kn = (bf16_t*)(ws + WS_KN); bf16_t* const vm = (bf16_t*)(ws + WS_VM); const float* const ssq_kv = (const float*)(ws + OFF_SSQ_KV);
        int t_ = threadIdx.x; asm volatile("" : "+v"(t_)); const int fr = t_ & 15, fq = (t_ >> 4) & 3;
        float sqv[2][4];
#pragma unroll
        for (int ai = 0; ai < 2; ++ai)
#pragma unroll
            for (int m = 0; m < 4; ++m) sqv[ai][m] = ssq_kv[u.pm * 256 + ai * 128 + wr * 64 + m * 16 + fr];
#pragma unroll
        for (int ai = 0; ai < 2; ++ai)
#pragma unroll
            for (int m = 0; m < 4; ++m) { const int row = u.pm * 256 + ai * 128 + wr * 64 + m * 16 + fr; const float rs = 1.0f / sqrtf(sqv[ai][m] * (1.0f / 256.0f) + EPS);
#pragma unroll
                for (int bj = 0; bj < 2; ++bj) { const int col = u.pn * 256 + bj * 128 + wc * 32 + 8 * fq; const int h = col >> 7, w = col & 127;
                    bf16_t* p = (w < 64) ? kn + (size_t)row * 512 + h * 64 + w : vm + (size_t)row * 512 + h * 64 + (w - 64);
                    *(v4u*)p = pack8(acc[ai][bj][m][0], acc[ai][bj][m][1], rs); } }
    }
};
struct EpiRes {
    static constexpr bool PERM = true, AFTER_DRAIN = false;
    const float* x; bf16* x1; unsigned char* ws; int dry;
    __device__ __forceinline__ void operator()(const f32x4 (&acc)[2][2][4][2], const Unit& u, int wr, int wc, int fr_in, int fq_in) const {
        const float* const mod = (const float*)(ws + WS_MOD); float* const ssq1 = (float*)(ws + OFF_SSQ_1);
        int t_ = threadIdx.x; asm volatile("" : "+v"(t_)); const int fr = t_ & 15, fq = (t_ >> 4) & 3;
        const int b = (u.pm * 256) / S;
        f32x4 gv[2][2];
#pragma unroll
        for (int bj = 0; bj < 2; ++bj) { const f32x4* gp = (const f32x4*)(mod + b * 6 * D + 2 * D + u.pn * 256 + bj * 128 + wc * 32 + 8 * fq); gv[bj][0] = gp[0]; gv[bj][1] = gp[1]; }
#pragma unroll
        for (int ai = 0; ai < 2; ++ai) {
            v4u xv[4][2];
#pragma unroll
            for (int m = 0; m < 4; ++m)
#pragma unroll
                for (int bj = 0; bj < 2; ++bj) { const int row = u.pm * 256 + ai * 128 + wr * 64 + m * 16 + fr, col = u.pn * 256 + bj * 128 + wc * 32 + 8 * fq;
                    xv[m][bj] = *(const v4u*)(x1 + (size_t)row * D + col); }
#pragma unroll
            for (int m = 0; m < 4; ++m) { const int row = u.pm * 256 + ai * 128 + wr * 64 + m * 16 + fr; float ss = 0.f;
#pragma unroll
                for (int bj = 0; bj < 2; ++bj) { const int col = u.pn * 256 + bj * 128 + wc * 32 + 8 * fq;
                    const unsigned xa_ = xv[m][bj].x, xb_ = xv[m][bj].y, xc_ = xv[m][bj].z, xd_ = xv[m][bj].w;
                    const f32x4 o0 = (f32x4){bflo(xa_), bfhi(xa_), bflo(xb_), bfhi(xb_)} + gv[bj][0] * acc[ai][bj][m][0], o1 = (f32x4){bflo(xc_), bfhi(xc_), bflo(xd_), bfhi(xd_)} + gv[bj][1] * acc[ai][bj][m][1];
                    *(v4u*)(x1 + (size_t)row * D + col) = (v4u){pk2(o0[0], o0[1]), pk2(o0[2], o0[3]), pk2(o1[0], o1[1]), pk2(o1[2], o1[3])}; ss += sq8(o0, o1); }
                ss += lane_xor16(ss); ss += lane_xor32(ss); if (fq == 0 && !dry) atomicAdd(ssq1 + row, ss); }
        }
    }
};
struct EpiF32 {
    static constexpr bool PERM = true, AFTER_DRAIN = false;
    float* o; int ld;
    __device__ __forceinline__ void operator()(const f32x4 (&acc)[2][2][4][2], const Unit& u, int wr, int wc, int fr_in, int fq_in) const {
        int t_ = threadIdx.x; asm volatile("" : "+v"(t_)); const int fr = t_ & 15, fq = (t_ >> 4) & 3;
#pragma unroll
        for (int ai = 0; ai < 2; ++ai)
#pragma unroll
            for (int m = 0; m < 4; ++m) { const int row = u.pm * 256 + ai * 128 + wr * 64 + m * 16 + fr;
#pragma unroll
                for (int bj = 0; bj < 2; ++bj) { const int col = u.pn * 256 + bj * 128 + wc * 32 + 8 * fq; f32x4* op = (f32x4*)(o + (size_t)row * ld + col); op[0] = acc[ai][bj][m][0]; op[1] = acc[ai][bj][m][1]; } }
    }
};
}

namespace att {
__device__ __forceinline__ int crow(int r, int hi) { return (r & 3) + 8 * (r >> 2) + 4 * hi; }
constexpr int VP = 192;
constexpr int BIAS_OFF = 2 * (64 * 208 + 64 * VP);
constexpr int BT_GUARD = 96;
constexpr int UNI_OFF = BIAS_OFF + 4608;
__device__ __forceinline__ int t5_bucket(int d) {
    if (d < 16) return d;
    int b = 16;
    b += (d >= 21); b += (d >= 27); b += (d >= 35); b += (d >= 46); b += (d >= 59); b += (d >= 77); b += (d >= 99); b += (d >= 128);
    b += (d >= 166); b += (d >= 216); b += (d >= 280); b += (d >= 363); b += (d >= 470); b += (d >= 609); b += (d >= 790);
    return b;
}
struct MergeCtx { const unsigned* selm; const unsigned short* qp; const bf16* po; const float* pml; const LAS unsigned* pbase; int fill_table; };
template <bool MOBA>
__device__ __forceinline__ void softmax_pv(f32x16& p0, f32x16& p1, f32x16& o0, f32x16& o1, f32x16& negm, float& mrun, f32x16& osum, const LAS unsigned char* vb, int lane, int hi) {
                float mxa = __builtin_fmaxf(__builtin_fmaxf(p0[0], p0[1]), p1[0]), mxb = __builtin_fmaxf(__builtin_fmaxf(p0[2], p0[3]), p1[1]);
                mxa = __builtin_fmaxf(__builtin_fmaxf(mxa, p1[2]), p1[3]);
#pragma unroll
                for (int r = 4; r < 16; r += 4) { mxa = __builtin_fmaxf(__builtin_fmaxf(mxa, p0[r]), p0[r + 1]); mxb = __builtin_fmaxf(__builtin_fmaxf(mxb, p0[r + 2]), p0[r + 3]);
                    mxa = __builtin_fmaxf(__builtin_fmaxf(mxa, p1[r]), p1[r + 1]); mxb = __builtin_fmaxf(__builtin_fmaxf(mxb, p1[r + 2]), p1[r + 3]); }
                float mx = __builtin_fmaxf(mxa, mxb);
                mx = fmaxf(mx, lane_xor32(mx));
                if (__any(mx > 8.f)) {
                    const float dl = fmaxf(mx, 0.f); const float alpha = __builtin_amdgcn_exp2f(-dl); mrun += dl; osum[0] *= alpha;
                    const float nm = (!MOBA) ? -mrun : -mrun * (1.0f / QS_MOBA);
#pragma unroll
                    for (int r = 0; r < 16; ++r) { o0[r] *= alpha; o1[r] *= alpha; p0[r] -= dl; p1[r] -= dl; negm[r] = nm; }
                }
#pragma unroll
                for (int r = 0; r < 16; ++r) { p0[r] = __builtin_amdgcn_exp2f(p0[r]); p1[r] = __builtin_amdgcn_exp2f(p1[r]); }
                v4u pw[4];
#pragma unroll
                for (int s = 0; s < 4; ++s) {
                    const f32x16& P = (s < 2) ? p0 : p1; const int rb = 8 * (s & 1);
                    pw[s].x = pk2(P[rb + 0], P[rb + 1]); pw[s].y = pk2(P[rb + 2], P[rb + 3]); pw[s].z = pk2(P[rb + 4], P[rb + 5]); pw[s].w = pk2(P[rb + 6], P[rb + 7]);
                }
                const int vlane = ((lane & 15) >> 2) * VP + (((lane >> 4) & 1) * 16 + 4 * (lane & 3)) * 2;
                const short one_ = ((lane & 31) == 0) ? (short)0x3F80 : (short)0;
                const bf16x8 ones = {one_, one_, one_, one_, one_, one_, one_, one_};
#pragma unroll
                for (int s = 0; s < 4; ++s) {
                    const int kbs = (s >> 1) * 32 + 16 * (s & 1) + 4 * hi;
                    osum = __builtin_amdgcn_mfma_f32_32x32x16_bf16(ones, __builtin_bit_cast(bf16x8, pw[s]), osum, 0, 0, 0);
#pragma unroll
                    for (int d0 = 0; d0 < 2; ++d0) {
                        const LAS unsigned char* vp = vb + kbs * VP + vlane + d0 * 64;
                        const s16x4 lo = __builtin_bit_cast(s16x4, __builtin_amdgcn_ds_read_tr16_b64_v4i16((LAS s16x4*)(vp)));
                        const s16x4 hh = __builtin_bit_cast(s16x4, __builtin_amdgcn_ds_read_tr16_b64_v4i16((LAS s16x4*)(vp + 8 * VP)));
                        const bf16x8 vf = (bf16x8){lo[0], lo[1], lo[2], lo[3], hh[0], hh[1], hh[2], hh[3]};
                        if (d0 == 0) o0 = __builtin_amdgcn_mfma_f32_32x32x16_bf16(vf, __builtin_bit_cast(bf16x8, pw[s]), o0, 0, 0, 0);
                        else o1 = __builtin_amdgcn_mfma_f32_32x32x16_bf16(vf, __builtin_bit_cast(bf16x8, pw[s]), o1, 0, 0, 0);
                    }
                }
}
template <int MODE>
__device__ __forceinline__ void attn_unit(LAS unsigned char* lds, int b, int h, int qb, const bf16* __restrict__ Q, const bf16* __restrict__ K1, const bf16* __restrict__ K2,
                                          const bf16* __restrict__ V, const float* __restrict__ kmean, const float* __restrict__ rel_bias, bf16* __restrict__ O, int ocol0, const MergeCtx* mc = nullptr) {
    constexpr int DQ = MODE == 0 ? 96 : 64, KP = MODE == 0 ? 208 : 144, NKS = DQ / 16, KTB = 64 * KP, STAGE = KTB + 64 * VP;
    const int tid = opaque_tid(), lane = tid & 63, r32 = lane & 31, hi = lane >> 5; const int wid = __builtin_amdgcn_readfirstlane(tid >> 6);
    const size_t rowbase = (size_t)b * S; const int q0 = qb * 256; const int qin = wid * 32 + r32;
    const size_t tq = rowbase + q0 + qin;
    bf16x8 qr[NKS];
    { const bf16* qp = (MODE == 0) ? Q + tq * 768 + h * 96 : Q + tq * 512 + h * 64;
#pragma unroll
      for (int d0 = 0; d0 < NKS; ++d0) qr[d0] = *(const bf16x8*)(qp + d0 * 16 + hi * 8); }
    if (MODE == 0) {
        const f32x4* cs = (const f32x4*)(kmean + (tq * 16 + 8 * hi) * 2);
        bf16x8 a = qr[NKS - 2], c = qr[NKS - 1];
#pragma unroll
        for (int jj = 0; jj < 4; ++jj) { const f32x4 t4 = cs[jj];
#pragma unroll
            for (int e = 0; e < 2; ++e) { const int j = 2 * jj + e; const float x1 = bflo((unsigned)(unsigned short)a[j]), x2 = bflo((unsigned)(unsigned short)c[j]); const float co = t4[2 * e], si = t4[2 * e + 1];
                a[j] = (short)f2bf(x1 * co - x2 * si); c[j] = (short)f2bf(x2 * co + x1 * si); } }
        qr[NKS - 2] = a; qr[NKS - 1] = c;
    }
    unsigned selmask = 0xffffu, uni = 0xffffu;
    if (MODE == 1) {
        LAS float* bt = (LAS float*)(lds + BIAS_OFF);
        for (int i = tid; i < BT_GUARD + 1024; i += 512) bt[i] = (i < BT_GUARD) ? -1e30f : rel_bias[t5_bucket(i - BT_GUARD) * 8 + h] * LOG2E;
        if (qb > 3) {
            float g[16];
#pragma unroll
            for (int n = 0; n < 16; ++n) { float a = 0.f;
                if (n < qb) { const float* km = kmean + ((size_t)(b * 8 + h) * 16 + n) * 64 + hi * 8;
#pragma unroll
                    for (int d0 = 0; d0 < 4; ++d0) { const f32x4 k0 = *(const f32x4*)(km + d0 * 16), k1 = *(const f32x4*)(km + d0 * 16 + 4); const bf16x8 qq = qr[d0];
                        a += bflo((unsigned)(unsigned short)qq[0]) * k0[0] + bflo((unsigned)(unsigned short)qq[1]) * k0[1] + bflo((unsigned)(unsigned short)qq[2]) * k0[2] + bflo((unsigned)(unsigned short)qq[3]) * k0[3]
                           + bflo((unsigned)(unsigned short)qq[4]) * k1[0] + bflo((unsigned)(unsigned short)qq[5]) * k1[1] + bflo((unsigned)(unsigned short)qq[6]) * k1[2] + bflo((unsigned)(unsigned short)qq[7]) * k1[3]; }
                    a += lane_xor32(a); }
                g[n] = a; }
            unsigned mk = 0;
#pragma unroll
            for (int r = 0; r < 3; ++r) { int bi = 0; float bv = -INFINITY;
#pragma unroll
                for (int n = 0; n < 16; ++n) if (n < qb && !((mk >> n) & 1u) && g[n] > bv) { bv = g[n]; bi = n; }
                mk |= 1u << bi; }
            selmask = mk;
        } else selmask = (1u << qb) - 1u;
        __syncthreads();
        { unsigned um = selmask;
#pragma unroll
          for (int o = 1; o < 64; o <<= 1) um |= __shfl_xor(um, o);
          if (lane == 0) ((LAS unsigned*)(lds + UNI_OFF))[wid] = um; }
        __syncthreads();
        uni = 0u;
#pragma unroll
        for (int w = 0; w < 8; ++w) uni |= ((const LAS unsigned*)(lds + UNI_OFF))[w];
    }
    if (MODE == 2) {
        if (mc->fill_table) { LAS float* bt = (LAS float*)(lds + BIAS_OFF);
            for (int i = tid; i < BT_GUARD + 1024; i += 512) bt[i] = (i < BT_GUARD) ? -1e30f : rel_bias[t5_bucket(i - BT_GUARD) * 8 + h] * LOG2E; }
        uni = 0u; selmask = 0u;
        __syncthreads();
    }
    float mk_[3] = {-1e30f, -1e30f, -1e30f}, lk_[3] = {0.f, 0.f, 0.f}; unsigned pi_[3] = {0u, 0u, 0u}; int ns = 0;
    if (MODE == 2) { unsigned mm = mc->selm[tq * 8 + h]; const int bh = b * 8 + h; const v2u qpw = *(const v2u*)(mc->qp + (tq * 8 + h) * 4);
        const unsigned qps[3] = {qpw.x & 0xffffu, qpw.x >> 16, qpw.y & 0xffffu};
#pragma unroll
        for (int k = 0; k < 3; ++k) { if (mm) { const int n = __builtin_ctz(mm); mm &= mm - 1u; const unsigned pidx = mc->pbase[bh * 15 + n] + qps[k];
                pi_[k] = pidx; mk_[k] = mc->pml[(size_t)pidx * 2]; lk_[k] = mc->pml[(size_t)pidx * 2 + 1]; ns = k + 1; } } }

    float mrun = 0.f; f32x16 osum = {};
    f32x16 o0 = {}, o1 = {}, negm = {};
    const int NT = 4 * (qb + 1);
    v4u kreg0, kreg1 = {}, vreg;
    const bf16* Kh = K1 + rowbase * 512 + h * 64; const bf16* Vh = V + rowbase * 512 + h * 64; const bf16* Krh = (MODE == 0) ? K2 + rowbase * 32 : nullptr;
#define LOAD_TILE(KT) do { const int k0_ = (KT) * 64; \
        if (MODE == 0) { \
            { const int p_ = tid, key_ = p_ / 12, c_ = p_ % 12; kreg0 = (c_ < 8) ? *(const v4u*)(Kh + (size_t)(k0_ + key_) * 512 + c_ * 8) : *(const v4u*)(Krh + (size_t)(k0_ + key_) * 32 + (c_ - 8) * 8); } \
            if (tid < 256) { const int p_ = 512 + tid, key_ = p_ / 12, c_ = p_ % 12; kreg1 = (c_ < 8) ? *(const v4u*)(Kh + (size_t)(k0_ + key_) * 512 + c_ * 8) : *(const v4u*)(Krh + (size_t)(k0_ + key_) * 32 + (c_ - 8) * 8); } \
        } else { const int key_ = tid >> 3, c_ = tid & 7; kreg0 = *(const v4u*)(Kh + (size_t)(k0_ + key_) * 512 + c_ * 8); } \
        { const int key_ = tid >> 3, c_ = tid & 7; vreg = *(const v4u*)(Vh + (size_t)(k0_ + key_) * 512 + c_ * 8); } } while (0)
#define STORE_TILE(ST) do { LAS unsigned char* kb_ = lds + (ST) * STAGE; LAS unsigned char* vb_ = kb_ + KTB; \
        if (MODE == 0) { \
            { const int p_ = tid, key_ = p_ / 12, c_ = p_ % 12; *(LAS v4u*)(kb_ + key_ * KP + c_ * 16) = kreg0; } \
            if (tid < 256) { const int p_ = 512 + tid, key_ = p_ / 12, c_ = p_ % 12; *(LAS v4u*)(kb_ + key_ * KP + c_ * 16) = kreg1; } \
        } else { const int key_ = tid >> 3, c_ = tid & 7; *(LAS v4u*)(kb_ + key_ * KP + c_ * 16) = kreg0; } \
        { const int key_ = tid >> 3, c_ = tid & 7; *(LAS v4u*)(vb_ + key_ * VP + c_ * 16) = vreg; } } while (0)
    int kt = 0;
    if (MODE != 0) { while (kt < 4 * qb && !((uni >> (kt >> 2)) & 1u)) kt += 4; }
    LOAD_TILE(kt); STORE_TILE(0);
    __syncthreads();
    int st = 0;
    while (kt < NT) {
        int ktn = kt + 1;
        if (MODE != 0) { while (ktn < 4 * qb && !((uni >> (ktn >> 2)) & 1u)) ktn += 4; }
        if (ktn < NT) LOAD_TILE(ktn);
        {
            const LAS unsigned char* kb = lds + st * STAGE; const LAS unsigned char* vb = kb + KTB;
            const int nblk = kt >> 2; const bool past = (MODE == 1) && (nblk < qb);
            bool active = true;
            if (past) active = __any((int)((selmask >> nblk) & 1u)) != 0;
            if (kt >= 4 * qb && (kt - 4 * qb) * 64 > wid * 32 + 31) active = false;
            if (active) {
                f32x16 p0, p1;
#pragma unroll
                for (int d0 = 0; d0 < NKS; ++d0) {
                    const bf16x8 a0 = *(const LAS bf16x8*)(kb + r32 * KP + (16 * d0 + 8 * hi) * 2);
                    const bf16x8 a1 = *(const LAS bf16x8*)(kb + (32 + r32) * KP + (16 * d0 + 8 * hi) * 2);
                    if (d0 == 0) { p0 = __builtin_amdgcn_mfma_f32_32x32x16_bf16(a0, qr[0], negm, 0, 0, 0); p1 = __builtin_amdgcn_mfma_f32_32x32x16_bf16(a1, qr[0], negm, 0, 0, 0); }
                    else { p0 = __builtin_amdgcn_mfma_f32_32x32x16_bf16(a0, qr[d0], p0, 0, 0, 0); p1 = __builtin_amdgcn_mfma_f32_32x32x16_bf16(a1, qr[d0], p1, 0, 0, 0); }
                }
                if (MODE == 0) {
                    if (kt >= 4 * qb) { const int kb0 = (kt - 4 * qb) * 64; asm volatile("" ::: "memory");
#pragma unroll
                        for (int r = 0; r < 16; ++r) { const int kk = kb0 + crow(r, hi); if (kk > qin) p0[r] = -1e30f; if (kk + 32 > qin) p1[r] = -1e30f; } }
                } else {
                    const LAS float* bt = (const LAS float*)(lds + BIAS_OFF);
                    const bool seld = !past || ((selmask >> nblk) & 1u);
                    const int dmin = (qb - nblk) * 256 + wid * 32 - (kt & 3) * 64 - 63;
                    if (dmin >= 790) { const float c31 = seld ? bt[BT_GUARD + 1023] : -1e30f;
#pragma unroll
                        for (int r = 0; r < 16; ++r) { p0[r] = p0[r] * QS_MOBA + c31; p1[r] = p1[r] * QS_MOBA + c31; } }
                    else {
                        const int D0 = (qb - nblk) * 256 + qin - (kt & 3) * 64 - 4 * hi;
                        const int bidx = seld ? (D0 + BT_GUARD - 59) : 0;
                        const LAS float* bp = bt + bidx;
#pragma unroll
                        for (int r = 0; r < 16; ++r) { const int kr = (r & 3) + 8 * (r >> 2);
                            p0[r] = p0[r] * QS_MOBA + bp[59 - kr]; p1[r] = p1[r] * QS_MOBA + bp[59 - kr - 32]; } }
                }
                softmax_pv<MODE != 0>(p0, p1, o0, o1, negm, mrun, osum, vb, lane, hi);
            }
        }
        if (ktn < NT) STORE_TILE(st ^ 1);
        __syncthreads();
        st ^= 1; kt = ktn;
    }
    const float lrun = osum[0]; const float lt = lrun + lane_xor32(lrun); float il = 1.0f / fmaxf(lt, 1e-30f);
    if (MODE == 2) {
        float M = mrun;
#pragma unroll
        for (int k = 0; k < 3; ++k) M = fmaxf(M, mk_[k]);
        const float w0 = __builtin_amdgcn_exp2f(mrun - M);
        float den = lt * w0;
#pragma unroll
        for (int r = 0; r < 16; ++r) { o0[r] *= w0; o1[r] *= w0; }
#pragma unroll
        for (int k = 0; k < 3; ++k) { if (k < ns) { const float wk = lk_[k] * __builtin_amdgcn_exp2f(mk_[k] - M); den += wk; const bf16* pp = mc->po + (size_t)pi_[k] * 64 + 4 * hi;
#pragma unroll
                for (int g4 = 0; g4 < 4; ++g4) { const v2u a = *(const v2u*)(pp + 8 * g4), c = *(const v2u*)(pp + 32 + 8 * g4);
                    o0[4 * g4] += wk * bflo(a.x); o0[4 * g4 + 1] += wk * bfhi(a.x); o0[4 * g4 + 2] += wk * bflo(a.y); o0[4 * g4 + 3] += wk * bfhi(a.y);
                    o1[4 * g4] += wk * bflo(c.x); o1[4 * g4 + 1] += wk * bfhi(c.x); o1[4 * g4 + 2] += wk * bflo(c.y); o1[4 * g4 + 3] += wk * bfhi(c.y); } } }
        il = 1.0f / fmaxf(den, 1e-30f);
    }
    bf16* op = O + tq * 1024 + ocol0 + h * 64;
#pragma unroll
    for (int g4 = 0; g4 < 4; ++g4) {
        v2u w0, w1;
        w0.x = pk2(o0[4 * g4 + 0] * il, o0[4 * g4 + 1] * il); w0.y = pk2(o0[4 * g4 + 2] * il, o0[4 * g4 + 3] * il);
        w1.x = pk2(o1[4 * g4 + 0] * il, o1[4 * g4 + 1] * il); w1.y = pk2(o1[4 * g4 + 2] * il, o1[4 * g4 + 3] * il);
        *(v2u*)(op + 8 * g4 + 4 * hi) = w0; *(v2u*)(op + 32 + 8 * g4 + 4 * hi) = w1;
    }
    __syncthreads();
#undef LOAD_TILE
#undef STORE_TILE
}

__device__ __forceinline__ void moba_past_sub(LAS unsigned char* lds, int b, int h, int n, int sub, unsigned cnt, unsigned pbase, const unsigned short* __restrict__ list, const bf16* __restrict__ MQp,
                                              const bf16* __restrict__ MKp, const bf16* __restrict__ MVp, const float* __restrict__ rel_bias, bf16* __restrict__ po, float* __restrict__ pml, bool fill_table) {
    constexpr int KP = 144, KTB = 64 * KP, VTB = 64 * VP, VOFF = 4 * KTB, BT_OFF = VOFF + 4 * VTB;
    const int tid = opaque_tid(), lane = tid & 63, r32 = lane & 31, hi = lane >> 5; const int wid = __builtin_amdgcn_readfirstlane(tid >> 6);
    const size_t rowbase = (size_t)b * S;
    { const bf16* Kh = MKp + (rowbase + (size_t)n * 256) * 512 + h * 64; const bf16* Vh = MVp + (rowbase + (size_t)n * 256) * 512 + h * 64;
#pragma unroll
      for (int i = 0; i < 4; ++i) { const int p = tid + 512 * i, key = p >> 3, c = p & 7;
          const v4u kv = *(const v4u*)(Kh + (size_t)key * 512 + c * 8), vv = *(const v4u*)(Vh + (size_t)key * 512 + c * 8);
          *(LAS v4u*)(lds + key * KP + c * 16) = kv; *(LAS v4u*)(lds + VOFF + key * VP + c * 16) = vv; }
      if (fill_table) { LAS float* bt = (LAS float*)(lds + BT_OFF);
          for (int i = tid; i < BT_GUARD + 1024; i += 512) bt[i] = (i < BT_GUARD) ? -1e30f : rel_bias[t5_bucket(i - BT_GUARD) * 8 + h] * LOG2E; } }
    __syncthreads();
#pragma unroll 1
    for (int c2 = 0; c2 < 2; ++c2) {
    const unsigned chunk = (unsigned)(sub * 16 + c2 * 8 + wid);
    if (chunk * 32u < cnt) {
        const unsigned e = chunk * 32u + (unsigned)r32; const bool valid = e < cnt; const unsigned ent = list[valid ? e : chunk * 32u];
        const int qpos = (int)(ent & 4095u);
        bf16x8 qr[4];
        { const bf16* qp = MQp + (rowbase + (size_t)qpos) * 512 + h * 64;
#pragma unroll
          for (int d0 = 0; d0 < 4; ++d0) qr[d0] = *(const bf16x8*)(qp + d0 * 16 + hi * 8); }
        float mrun = 0.f; f32x16 o0 = {}, o1 = {}, negm = {}, osum = {};
        const LAS float* bt = (const LAS float*)(lds + BT_OFF);
#pragma unroll 1
        for (int kt = 0; kt < 4; ++kt) {
            const LAS unsigned char* kb = lds + kt * KTB; const LAS unsigned char* vb = lds + VOFF + kt * VTB;
            f32x16 p0, p1;
#pragma unroll
            for (int d0 = 0; d0 < 4; ++d0) {
                const bf16x8 a0 = *(const LAS bf16x8*)(kb + r32 * KP + (16 * d0 + 8 * hi) * 2), a1 = *(const LAS bf16x8*)(kb + (32 + r32) * KP + (16 * d0 + 8 * hi) * 2);
                if (d0 == 0) { p0 = __builtin_amdgcn_mfma_f32_32x32x16_bf16(a0, qr[0], negm, 0, 0, 0); p1 = __builtin_amdgcn_mfma_f32_32x32x16_bf16(a1, qr[0], negm, 0, 0, 0); }
                else { p0 = __builtin_amdgcn_mfma_f32_32x32x16_bf16(a0, qr[d0], p0, 0, 0, 0); p1 = __builtin_amdgcn_mfma_f32_32x32x16_bf16(a1, qr[d0], p1, 0, 0, 0); }
            }
            const int D0 = qpos - (n * 256 + kt * 64) - 4 * hi;
            if (__all(D0 - 59 >= 790)) { const float c31 = bt[BT_GUARD + 1023];
#pragma unroll
                for (int r = 0; r < 16; ++r) { p0[r] = p0[r] * QS_MOBA + c31; p1[r] = p1[r] * QS_MOBA + c31; } }
            else { const int bidx = min(D0, 1023) + BT_GUARD - 59; const LAS float* bp = bt + bidx;
#pragma unroll
                for (int r = 0; r < 16; ++r) { const int kr = (r & 3) + 8 * (r >> 2); p0[r] = p0[r] * QS_MOBA + bp[59 - kr]; p1[r] = p1[r] * QS_MOBA + bp[59 - kr - 32]; } }
            softmax_pv<true>(p0, p1, o0, o1, negm, mrun, osum, vb, lane, hi);
        }
        const float lrun = osum[0]; const float lt = lrun + lane_xor32(lrun); const float il = 1.0f / fmaxf(lt, 1e-30f);
        if (valid) {
            const size_t pidx = (size_t)pbase + e; bf16* op = po + pidx * 64 + 4 * hi;
#pragma unroll
            for (int g4 = 0; g4 < 4; ++g4) { v2u w0, w1;
                w0.x = pk2(o0[4 * g4 + 0] * il, o0[4 * g4 + 1] * il); w0.y = pk2(o0[4 * g4 + 2] * il, o0[4 * g4 + 3] * il);
                w1.x = pk2(o1[4 * g4 + 0] * il, o1[4 * g4 + 1] * il); w1.y = pk2(o1[4 * g4 + 2] * il, o1[4 * g4 + 3] * il);
                *(v2u*)(op + 8 * g4) = w0; *(v2u*)(op + 32 + 8 * g4) = w1; }
            if (hi == 0) { pml[pidx * 2] = mrun; pml[pidx * 2 + 1] = lt; }
        }
    }
    }
    __syncthreads();
}

__device__ __forceinline__ void mla_pv(f32x16& o0, f32x16& o1, f32x16& osum, const v4u (&pw)[4], const LAS unsigned char* vb, int lane, int hi) {
    const short one_ = ((lane & 31) == 0) ? (short)0x3F80 : (short)0;
    const bf16x8 ones = {one_, one_, one_, one_, one_, one_, one_, one_};
    const int vlane = ((lane & 15) >> 2) * VP + (((lane >> 4) & 1) * 16 + 4 * (lane & 3)) * 2;
#pragma unroll
    for (int s = 0; s < 4; ++s) {
        const int kbs = (s >> 1) * 32 + 16 * (s & 1) + 4 * hi;
        osum = __builtin_amdgcn_mfma_f32_32x32x16_bf16(ones, __builtin_bit_cast(bf16x8, pw[s]), osum, 0, 0, 0);
#pragma unroll
        for (int d0 = 0; d0 < 2; ++d0) {
            const LAS unsigned char* vp = vb + kbs * VP + vlane + d0 * 64;
            const s16x4 lo = __builtin_bit_cast(s16x4, __builtin_amdgcn_ds_read_tr16_b64_v4i16((LAS s16x4*)(vp)));
            const s16x4 hh = __builtin_bit_cast(s16x4, __builtin_amdgcn_ds_read_tr16_b64_v4i16((LAS s16x4*)(vp + 8 * VP)));
            const bf16x8 vf = (bf16x8){lo[0], lo[1], lo[2], lo[3], hh[0], hh[1], hh[2], hh[3]};
            if (d0 == 0) o0 = __builtin_amdgcn_mfma_f32_32x32x16_bf16(vf, __builtin_bit_cast(bf16x8, pw[s]), o0, 0, 0, 0);
            else o1 = __builtin_amdgcn_mfma_f32_32x32x16_bf16(vf, __builtin_bit_cast(bf16x8, pw[s]), o1, 0, 0, 0);
        }
    }
}
template <int VFIRST> __device__ __forceinline__ void mla_unit2(LAS unsigned char* lds, int b, int h, int qb, const bf16* __restrict__ Q, const bf16* __restrict__ K1, const bf16* __restrict__ K2,
                                          const bf16* __restrict__ V, const float* __restrict__ ropet, bf16* __restrict__ O) {
    constexpr int KP = 208, NKS = 6, KTB = 64 * KP, VTB = 64 * VP, VOFF = 2 * KTB;
    const int tid = opaque_tid(), lane = tid & 63, r32 = lane & 31, hi = lane >> 5; const int wid = __builtin_amdgcn_readfirstlane(tid >> 6);
    const size_t rowbase = (size_t)b * S; const int q0 = qb * 256; const int qin = wid * 32 + r32; const size_t tq = rowbase + q0 + qin;
    bf16x8 qr[NKS];
    { const bf16* qp = Q + tq * 768 + h * 96;
#pragma unroll
      for (int d0 = 0; d0 < NKS; ++d0) qr[d0] = *(const bf16x8*)(qp + d0 * 16 + hi * 8); }
    { const f32x4* cs = (const f32x4*)(ropet + (tq * 16 + 8 * hi) * 2);
      bf16x8 a = qr[NKS - 2], c = qr[NKS - 1];
#pragma unroll
      for (int jj = 0; jj < 4; ++jj) { const f32x4 t4 = cs[jj];
#pragma unroll
          for (int e = 0; e < 2; ++e) { const int j = 2 * jj + e; const float x1 = bflo((unsigned)(unsigned short)a[j]), x2 = bflo((unsigned)(unsigned short)c[j]); const float co = t4[2 * e], si = t4[2 * e + 1];
              a[j] = (short)f2bf(x1 * co - x2 * si); c[j] = (short)f2bf(x2 * co + x1 * si); } }
      qr[NKS - 2] = a; qr[NKS - 1] = c; }
    float mrun = 0.f; f32x16 osum = {}, o0 = {}, o1 = {}, negm = {};
    const int NF = 4 * qb, NT = NF + 4;
    v4u kreg0, kreg1 = {}, vreg;
    const bf16* Kh = K1 + rowbase * 512 + h * 64; const bf16* Vh = V + rowbase * 512 + h * 64; const bf16* Krh = K2 + rowbase * 32;
#define LOADT(KT) do { const int k0_ = (KT) * 64; \
        { const int p_ = ltid, key_ = p_ / 12, c_ = p_ % 12; kreg0 = (c_ < 8) ? *(const v4u*)(Kh + (size_t)(k0_ + key_) * 512 + c_ * 8) : *(const v4u*)(Krh + (size_t)(k0_ + key_) * 32 + (c_ - 8) * 8); } \
        if (ltid < 256) { const int p_ = 512 + ltid, key_ = p_ / 12, c_ = p_ % 12; kreg1 = (c_ < 8) ? *(const v4u*)(Kh + (size_t)(k0_ + key_) * 512 + c_ * 8) : *(const v4u*)(Krh + (size_t)(k0_ + key_) * 32 + (c_ - 8) * 8); } \
        { const int key_ = ltid >> 3, c_ = ltid & 7; vreg = *(const v4u*)(Vh + (size_t)(k0_ + key_) * 512 + c_ * 8); } } while (0)
#define STORET(KT) do { LAS unsigned char* kb_ = lds + ((KT) & 1) * KTB; LAS unsigned char* vb_ = lds + VOFF + ((KT) & 3) * VTB; \
        { const int p_ = ltid, key_ = p_ / 12, c_ = p_ % 12; *(LAS v4u*)(kb_ + key_ * KP + c_ * 16) = kreg0; } \
        if (ltid < 256) { const int p_ = 512 + ltid, key_ = p_ / 12, c_ = p_ % 12; *(LAS v4u*)(kb_ + key_ * KP + c_ * 16) = kreg1; } \
        { const int key_ = ltid >> 3, c_ = ltid & 7; *(LAS v4u*)(vb_ + key_ * VP + c_ * 16) = vreg; } } while (0)
#define QKH(KT, PP, HALF) do { const LAS unsigned char* kb_ = lds + ((KT) & 1) * KTB + ((HALF) * 32 + r32) * KP + 16 * hi; \
        _Pragma("unroll") for (int d0 = 0; d0 < NKS; ++d0) { const bf16x8 a_ = *(const LAS bf16x8*)(kb_ + 32 * d0); \
            PP = __builtin_amdgcn_mfma_f32_32x32x16_bf16(a_, qr[d0], d0 == 0 ? negm : PP, 0, 0, 0); } } while (0)
#define SMAX(P0, P1, N0, N1) do { \
        float mxa_ = __builtin_fmaxf(__builtin_fmaxf(P0[0], P0[1]), P1[0]), mxb_ = __builtin_fmaxf(__builtin_fmaxf(P0[2], P0[3]), P1[1]); \
        mxa_ = __builtin_fmaxf(__builtin_fmaxf(mxa_, P1[2]), P1[3]); \
        _Pragma("unroll") for (int r = 4; r < 16; r += 4) { mxa_ = __builtin_fmaxf(__builtin_fmaxf(mxa_, P0[r]), P0[r + 1]); mxb_ = __builtin_fmaxf(__builtin_fmaxf(mxb_, P0[r + 2]), P0[r + 3]); \
            mxa_ = __builtin_fmaxf(__builtin_fmaxf(mxa_, P1[r]), P1[r + 1]); mxb_ = __builtin_fmaxf(__builtin_fmaxf(mxb_, P1[r + 2]), P1[r + 3]); } \
        float mx_ = __builtin_fmaxf(mxa_, mxb_); mx_ = fmaxf(mx_, lane_xor32(mx_)); \
        if (__any(mx_ > 8.f)) { const float dl_ = fmaxf(mx_, 0.f); const float alpha_ = __builtin_amdgcn_exp2f(-dl_); mrun += dl_; osum[0] *= alpha_; const float nm_ = -mrun; \
            _Pragma("unroll") for (int r = 0; r < 16; ++r) { o0[r] *= alpha_; o1[r] *= alpha_; P0[r] -= dl_; P1[r] -= dl_; N0[r] -= dl_; N1[r] -= dl_; negm[r] = nm_; } } } while (0)
#define SMAXB(P0, P1, APEND) do { \
        float mxa_ = __builtin_fmaxf(__builtin_fmaxf(P0[0], P0[1]), P1[0]), mxb_ = __builtin_fmaxf(__builtin_fmaxf(P0[2], P0[3]), P1[1]); \
        mxa_ = __builtin_fmaxf(__builtin_fmaxf(mxa_, P1[2]), P1[3]); \
        _Pragma("unroll") for (int r = 4; r < 16; r += 4) { mxa_ = __builtin_fmaxf(__builtin_fmaxf(mxa_, P0[r]), P0[r + 1]); mxb_ = __builtin_fmaxf(__builtin_fmaxf(mxb_, P0[r + 2]), P0[r + 3]); \
            mxa_ = __builtin_fmaxf(__builtin_fmaxf(mxa_, P1[r]), P1[r + 1]); mxb_ = __builtin_fmaxf(__builtin_fmaxf(mxb_, P1[r + 2]), P1[r + 3]); } \
        float mx_ = __builtin_fmaxf(mxa_, mxb_); mx_ = fmaxf(mx_, lane_xor32(mx_)); \
        if (__any(mx_ > 8.f)) { const float dl_ = fmaxf(mx_, 0.f); APEND = __builtin_amdgcn_exp2f(-dl_); mrun += dl_; const float nm_ = -mrun; \
            _Pragma("unroll") for (int r = 0; r < 16; ++r) { P0[r] -= dl_; P1[r] -= dl_; negm[r] = nm_; } } } while (0)
#define SEXP(P0, P1, PW) do { \
        _Pragma("unroll") for (int r = 0; r < 16; ++r) { P0[r] = __builtin_amdgcn_exp2f(P0[r]); P1[r] = __builtin_amdgcn_exp2f(P1[r]); } \
        _Pragma("unroll") for (int s_ = 0; s_ < 4; ++s_) { const int rb_ = 8 * (s_ & 1); \
            if (s_ < 2) { PW[s_].x = pk2(P0[rb_ + 0], P0[rb_ + 1]); PW[s_].y = pk2(P0[rb_ + 2], P0[rb_ + 3]); PW[s_].z = pk2(P0[rb_ + 4], P0[rb_ + 5]); PW[s_].w = pk2(P0[rb_ + 6], P0[rb_ + 7]); } \
            else { PW[s_].x = pk2(P1[rb_ + 0], P1[rb_ + 1]); PW[s_].y = pk2(P1[rb_ + 2], P1[rb_ + 3]); PW[s_].z = pk2(P1[rb_ + 4], P1[rb_ + 5]); PW[s_].w = pk2(P1[rb_ + 6], P1[rb_ + 7]); } } } while (0)
#define LTID_ int ltid = tid; asm volatile("" : "+v"(ltid))
    { LTID_; LOADT(0); STORET(0); LOADT(1); STORET(1); }
    __syncthreads();
    f32x16 p0, p1;
    QKH(0, p0, 0); QKH(0, p1, 1);
    v4u pwp[4] = {};
    if (!VFIRST) {
#pragma unroll 1
        for (int t = 0; t < NF; ++t) {
            LTID_; LOADT(t + 2);
            f32x16 n0, n1; v4u pw[4];
            QKH(t + 1, n0, 0);
            mla_pv(o0, o1, osum, pwp, lds + VOFF + (t == 0 ? 0 : ((t - 1) & 3)) * VTB, lane, hi);
            { f32x16 dmy_ = {}; SMAX(p0, p1, n0, dmy_); }
            QKH(t + 1, n1, 1);
            SEXP(p0, p1, pw);
#pragma unroll
            for (int s_ = 0; s_ < 4; ++s_) pwp[s_] = pw[s_];
            p0 = n0; p1 = n1;
            STORET(t + 2);
            __syncthreads();
        }
    } else {
#pragma unroll 1
        for (int t = 0; t < NF; ++t) {
            LTID_; LOADT(t + 2);
            f32x16 n0, n1; v4u pw[4]; float apend = 1.f;
            SMAXB(p0, p1, apend);
            SEXP(p0, p1, pw);
            __builtin_amdgcn_sched_barrier(0);
            QKH(t + 1, n0, 0); QKH(t + 1, n1, 1);
            mla_pv(o0, o1, osum, pwp, lds + VOFF + (t == 0 ? 0 : ((t - 1) & 3)) * VTB, lane, hi);
            if (__any(apend != 1.f)) { osum[0] *= apend;
#pragma unroll
                for (int r = 0; r < 16; ++r) { o0[r] *= apend; o1[r] *= apend; } }
#pragma unroll
            for (int s_ = 0; s_ < 4; ++s_) pwp[s_] = pw[s_];
            p0 = n0; p1 = n1;
            STORET(t + 2);
            __syncthreads();
        }
    }
    if (NF > 0) mla_pv(o0, o1, osum, pwp, lds + VOFF + ((NF - 1) & 3) * VTB, lane, hi);
#pragma unroll 1
    for (int d = 0; d < 4; ++d) { const int t = NF + d; LTID_;
        if (d < 2) LOADT(t + 2);
        const bool active = !(d * 64 > wid * 32 + 31);
        if (active) {
            { const int kb0 = d * 64;
#pragma unroll
              for (int r = 0; r < 16; ++r) { const int kk = kb0 + crow(r, hi); if (kk > qin) p0[r] = -1e30f; if (kk + 32 > qin) p1[r] = -1e30f; } }
            f32x16 dm0 = {}, dm1 = {};
            SMAX(p0, p1, dm0, dm1);
            v4u pw[4];
            SEXP(p0, p1, pw);
            mla_pv(o0, o1, osum, pw, lds + VOFF + (t & 3) * VTB, lane, hi);
        }
        if (d < 3) { QKH(t + 1, p0, 0); QKH(t + 1, p1, 1); }
        if (d < 2) STORET(t + 2);
        __syncthreads();
    }
    const float lrun = osum[0]; const float lt = lrun + lane_xor32(lrun); const float il = 1.0f / fmaxf(lt, 1e-30f);
    bf16* op = O + tq * 1024 + h * 64;
#pragma unroll
    for (int g4 = 0; g4 < 4; ++g4) {
        v2u w0, w1;
        w0.x = pk2(o0[4 * g4 + 0] * il, o0[4 * g4 + 1] * il); w0.y = pk2(o0[4 * g4 + 2] * il, o0[4 * g4 + 3] * il);
        w1.x = pk2(o1[4 * g4 + 0] * il, o1[4 * g4 + 1] * il); w1.y = pk2(o1[4 * g4 + 2] * il, o1[4 * g4 + 3] * il);
        *(v2u*)(op + 8 * g4 + 4 * hi) = w0; *(v2u*)(op + 32 + 8 * g4 + 4 * hi) = w1;
    }
    __syncthreads();
#undef LTID_
#undef LOADT
#undef STORET
#undef QKH
#undef SMAX
#undef SEXP
}

__device__ __forceinline__ void moba_own_unit(LAS unsigned char* lds, int b, int h, int qb, const bf16* __restrict__ MQp, const bf16* __restrict__ MKp, const bf16* __restrict__ MVp,
                                              const float* __restrict__ rel_bias, bf16* __restrict__ O, int ocol0, const MergeCtx* mc) {
    constexpr int KP = 144, KTB = 64 * KP, VTB = 64 * VP, VOFF = 4 * KTB, BT_OFF = VOFF + 4 * VTB;
    const int tid = opaque_tid(), lane = tid & 63, r32 = lane & 31, hi = lane >> 5; const int wid = __builtin_amdgcn_readfirstlane(tid >> 6);
    const size_t rowbase = (size_t)b * S; const int qin = wid * 32 + r32; const size_t tq = rowbase + (size_t)qb * 256 + qin;
    v4u kv_[4], vv_[4];
    { const bf16* Kh = MKp + (rowbase + (size_t)qb * 256) * 512 + h * 64; const bf16* Vh = MVp + (rowbase + (size_t)qb * 256) * 512 + h * 64;
#pragma unroll
      for (int i = 0; i < 4; ++i) { const int p = tid + 512 * i, key = p >> 3, c = p & 7; kv_[i] = *(const v4u*)(Kh + (size_t)key * 512 + c * 8); vv_[i] = *(const v4u*)(Vh + (size_t)key * 512 + c * 8); } }
    bf16x8 qr[4];
    { const bf16* qp = MQp + tq * 512 + h * 64;
#pragma unroll
      for (int d0 = 0; d0 < 4; ++d0) qr[d0] = *(const bf16x8*)(qp + d0 * 16 + hi * 8); }
    unsigned mm = mc->selm[tq * 8 + h]; const v2u qpw = *(const v2u*)(mc->qp + (tq * 8 + h) * 4);
    if (mc->fill_table) { LAS float* bt = (LAS float*)(lds + BT_OFF);
        for (int i = tid; i < BT_GUARD + 1024; i += 512) bt[i] = (i < BT_GUARD) ? -1e30f : rel_bias[t5_bucket(i - BT_GUARD) * 8 + h] * LOG2E; }
#pragma unroll
    for (int i = 0; i < 4; ++i) { const int p = tid + 512 * i, key = p >> 3, c = p & 7; *(LAS v4u*)(lds + key * KP + c * 16) = kv_[i]; *(LAS v4u*)(lds + VOFF + key * VP + c * 16) = vv_[i]; }
    bool ok_[3]; f32x2 ml_[3]; v2u pa_[3][4], pc_[3][4];
    { const int bh = b * 8 + h; const unsigned qps[3] = {qpw.x & 0xffffu, qpw.x >> 16, qpw.y & 0xffffu};
#pragma unroll
      for (int k = 0; k < 3; ++k) { ok_[k] = mm != 0u; const int n = ok_[k] ? __builtin_ctz(mm) : 0; mm &= mm - 1u; const unsigned pidx = ok_[k] ? mc->pbase[bh * 15 + n] + qps[k] : 0u;
          ml_[k] = *(const f32x2*)(mc->pml + (size_t)pidx * 2); const bf16* pp = mc->po + (size_t)pidx * 64 + 4 * hi;
#pragma unroll
          for (int g4 = 0; g4 < 4; ++g4) { pa_[k][g4] = *(const v2u*)(pp + 8 * g4); pc_[k][g4] = *(const v2u*)(pp + 32 + 8 * g4); } } }
    __syncthreads();
    float mrun = 0.f; f32x16 o0 = {}, o1 = {}, negm = {}, osum = {};
    const LAS float* bt = (const LAS float*)(lds + BT_OFF);
    const int ntile = ((wid * 32 + 31) >> 6) + 1;
#pragma unroll 1
    for (int kt = 0; kt < ntile; ++kt) {
        const LAS unsigned char* kb = lds + kt * KTB; const LAS unsigned char* vb = lds + VOFF + kt * VTB;
        f32x16 p0, p1;
#pragma unroll
        for (int d0 = 0; d0 < 4; ++d0) {
            const bf16x8 a0 = *(const LAS bf16x8*)(kb + r32 * KP + (16 * d0 + 8 * hi) * 2), a1 = *(const LAS bf16x8*)(kb + (32 + r32) * KP + (16 * d0 + 8 * hi) * 2);
            if (d0 == 0) { p0 = __builtin_amdgcn_mfma_f32_32x32x16_bf16(a0, qr[0], negm, 0, 0, 0); p1 = __builtin_amdgcn_mfma_f32_32x32x16_bf16(a1, qr[0], negm, 0, 0, 0); }
            else { p0 = __builtin_amdgcn_mfma_f32_32x32x16_bf16(a0, qr[d0], p0, 0, 0, 0); p1 = __builtin_amdgcn_mfma_f32_32x32x16_bf16(a1, qr[d0], p1, 0, 0, 0); }
        }
        const int D0 = qin - kt * 64 - 4 * hi;
        const LAS float* bp = bt + (D0 + BT_GUARD - 59);
#pragma unroll
        for (int r = 0; r < 16; ++r) { const int kr = (r & 3) + 8 * (r >> 2); p0[r] = p0[r] * QS_MOBA + bp[59 - kr]; p1[r] = p1[r] * QS_MOBA + bp[59 - kr - 32]; }
        softmax_pv<true>(p0, p1, o0, o1, negm, mrun, osum, vb, lane, hi);
    }
    const float lrun = osum[0]; const float lt = lrun + lane_xor32(lrun);
    float mk_[3], lk_[3];
#pragma unroll
    for (int k = 0; k < 3; ++k) { mk_[k] = ok_[k] ? ml_[k].x : -1e30f; lk_[k] = ok_[k] ? ml_[k].y : 0.f; }
    float M = mrun;
#pragma unroll
    for (int k = 0; k < 3; ++k) M = fmaxf(M, mk_[k]);
    const float w0 = __builtin_amdgcn_exp2f(mrun - M); float den = lt * w0;
#pragma unroll
    for (int r = 0; r < 16; ++r) { o0[r] *= w0; o1[r] *= w0; }
#pragma unroll
    for (int k = 0; k < 3; ++k) { const float wk = lk_[k] * __builtin_amdgcn_exp2f(mk_[k] - M); den += wk;
#pragma unroll
        for (int g4 = 0; g4 < 4; ++g4) { const v2u a = pa_[k][g4], c = pc_[k][g4];
            o0[4 * g4] += wk * bflo(a.x); o0[4 * g4 + 1] += wk * bfhi(a.x); o0[4 * g4 + 2] += wk * bflo(a.y); o0[4 * g4 + 3] += wk * bfhi(a.y);
            o1[4 * g4] += wk * bflo(c.x); o1[4 * g4 + 1] += wk * bfhi(c.x); o1[4 * g4 + 2] += wk * bflo(c.y); o1[4 * g4 + 3] += wk * bfhi(c.y); } }
    const float il = 1.0f / fmaxf(den, 1e-30f);
    bf16* op = O + tq * 1024 + ocol0 + h * 64;
#pragma unroll
    for (int g4 = 0; g4 < 4; ++g4) { v2u w0_, w1_;
        w0_.x = pk2(o0[4 * g4 + 0] * il, o0[4 * g4 + 1] * il); w0_.y = pk2(o0[4 * g4 + 2] * il, o0[4 * g4 + 3] * il);
        w1_.x = pk2(o1[4 * g4 + 0] * il, o1[4 * g4 + 1] * il); w1_.y = pk2(o1[4 * g4 + 2] * il, o1[4 * g4 + 3] * il);
        *(v2u*)(op + 8 * g4 + 4 * hi) = w0_; *(v2u*)(op + 32 + 8 * g4 + 4 * hi) = w1_; }
    __syncthreads();
}
}


namespace srt {
__device__ __forceinline__ void ce(float& a, float& b) { const float hi = fmaxf(a, b), lo = fminf(a, b); a = hi; b = lo; }
template <int N> __device__ __forceinline__ void sort_desc(float (&a)[N]) {
    static_assert(N == 16, "sort_desc: N = 16");
#pragma unroll
    for (int kk = 1; kk <= 4; ++kk)
#pragma unroll
        for (int jj = 3; jj >= 0; --jj) { if (jj < kk) { const int k = 1 << kk, j = 1 << jj;
#pragma unroll
            for (int i = 0; i < 16; ++i) { const int l = i ^ j; if (l > i) { if ((i & k) == 0) ce(a[i], a[l]); else ce(a[l], a[i]); } } } }
}
__device__ __forceinline__ void merge16(float (&a)[16], const float (&b)[16]) {
#pragma unroll
    for (int i = 0; i < 16; ++i) a[i] = fmaxf(a[i], b[15 - i]);
#pragma unroll
    for (int jj = 3; jj >= 0; --jj) { const int j = 1 << jj;
#pragma unroll
        for (int i = 0; i < 16; ++i) { const int l = i ^ j; if (l > i) ce(a[i], a[l]); } }
}
__device__ __forceinline__ void merge_partner(float (&a)[16], bool upper) {
    float b[16];
#pragma unroll
    for (int i = 0; i < 16; ++i) b[i] = __shfl_xor(a[i], 32);
    merge16(a, b);
}
struct Pairs { int a[50], b[50]; };
__host__ __device__ constexpr Pairs make_pairs() { Pairs p{}; int n = 0; for (int k0 = 0; k0 < 16; ++k0) for (int k1 = 0; k1 < 16; ++k1) if ((k0 + 1) * (k1 + 1) <= 16) { p.a[n] = k0; p.b[n] = k1; ++n; } return p; }
template <int I> __device__ __forceinline__ void cand_fill(const float (&s0)[16], const float (&s1)[16], int hi, float (&c0)[16], float (&c1)[16]) {
    float v = -INFINITY;
    if constexpr (I < 25) { constexpr Pairs P = make_pairs(); constexpr int a0 = P.a[I], b0 = P.b[I], a1 = P.a[25 + I], b1 = P.b[25 + I];
        const float va = s0[a0] + s1[b0], vb = s0[a1] + s1[b1]; const float x = hi ? vb : va; const unsigned cc = hi ? (unsigned)(a1 * 16 + b1) : (unsigned)(a0 * 16 + b0);
        v = __builtin_bit_cast(float, (__builtin_bit_cast(unsigned, x) & ~255u) | cc); }
    if constexpr (I < 16) c0[I] = v; else c1[I - 16] = v;
    if constexpr (I + 1 < 32) cand_fill<I + 1>(s0, s1, hi, c0, c1);
}
}


namespace peer {
struct Idx { v4u a, b, c, d; };
__device__ __forceinline__ Idx load_idx(const int* eidx, int t, int g) { const v4u* ip = (const v4u*)(eidx + (size_t)t * 128 + g * 16); Idx r; r.a = ip[0]; r.b = ip[1]; r.c = ip[2]; r.d = ip[3]; return r; }
__device__ __forceinline__ void load_rows(v4u (&R)[16], const Idx& I, const unsigned char* base, unsigned lo) {
#define PR_(i, e) R[i] = *(const v4u*)(base + ((e) * 128u + lo))
    PR_(0, I.a.x); PR_(1, I.a.y); PR_(2, I.a.z); PR_(3, I.a.w); PR_(4, I.b.x); PR_(5, I.b.y); PR_(6, I.b.z); PR_(7, I.b.w);
    PR_(8, I.c.x); PR_(9, I.c.y); PR_(10, I.c.z); PR_(11, I.c.w); PR_(12, I.d.x); PR_(13, I.d.y); PR_(14, I.d.z); PR_(15, I.d.w);
#undef PR_
}
__device__ __forceinline__ void dma_rows(LAS unsigned char* slot, const Idx& I, const unsigned char* base, unsigned lo) {
#define PD_(i, e) __builtin_amdgcn_global_load_lds((const unsigned*)(base + ((e) * 128u + lo)), (LAS unsigned*)(slot + (i) * 1024), 16, 0, 0)
    PD_(0, I.a.x); PD_(1, I.a.y); PD_(2, I.a.z); PD_(3, I.a.w); PD_(4, I.b.x); PD_(5, I.b.y); PD_(6, I.b.z); PD_(7, I.b.w);
    PD_(8, I.c.x); PD_(9, I.c.y); PD_(10, I.c.z); PD_(11, I.c.w); PD_(12, I.d.x); PD_(13, I.d.y); PD_(14, I.d.z); PD_(15, I.d.w);
#undef PD_
}
__device__ __forceinline__ void read_slot(v4u (&R)[16], const LAS unsigned char* slot, int lane) {
#pragma unroll
    for (int i = 0; i < 16; ++i) R[i] = *(const LAS v4u*)(slot + i * 1024 + lane * 16);
}
__device__ __forceinline__ f32x2 dots(const v4u (&R)[16], const float (&hf)[16], int c) {
    float pd[16];
    unsigned carry = R[0][0];
#pragma unroll
    for (int j = 0; j < 16; ++j) { float a = 0.f;
#pragma unroll
        for (int w = 0; w < 4; ++w) { const unsigned uw = (w == 0) ? carry : R[j][w]; const f32x2 lo = __builtin_amdgcn_cvt_pk_f32_fp8((int)uw, false), hh = __builtin_amdgcn_cvt_pk_f32_fp8((int)uw, true);
            a += hf[4 * w] * lo[0] + hf[4 * w + 1] * lo[1] + hf[4 * w + 2] * hh[0] + hf[4 * w + 3] * hh[1]; }
        if (j < 15) { carry = R[j + 1][0]; if (j & 1) asm volatile("" : "+v"(a), "+v"(carry)); }
        pd[j] = a; }
    float w8[8], w4[4], w2[2];
    { const bool up = (c & 4) != 0;
#pragma unroll
      for (int j = 0; j < 8; ++j) { const float send = up ? pd[j] : pd[8 + j]; const float keep = up ? pd[8 + j] : pd[j]; w8[j] = keep + __shfl_xor(send, 4); } }
    { const bool up = (c & 2) != 0;
#pragma unroll
      for (int j = 0; j < 4; ++j) { const float send = up ? w8[j] : w8[4 + j]; const float keep = up ? w8[4 + j] : w8[j]; w4[j] = keep + __shfl_xor(send, 2); } }
    { const bool up = (c & 1) != 0;
#pragma unroll
      for (int j = 0; j < 2; ++j) { const float send = up ? w4[j] : w4[2 + j]; const float keep = up ? w4[2 + j] : w4[j]; w2[j] = keep + __shfl_xor(send, 1); } }
    return (f32x2){w2[0], w2[1]};
}
template <int CTRL> __device__ __forceinline__ float dppf(float v) { return __builtin_bit_cast(float, __builtin_amdgcn_update_dpp(0, __builtin_bit_cast(int, v), CTRL, 0xf, 0xf, true)); }
template <int CTRL> __device__ __forceinline__ int dppi(int v) { return __builtin_amdgcn_update_dpp(0, v, CTRL, 0xf, 0xf, true); }
__device__ __forceinline__ float xor16f(float v, bool oddrow) { const auto r = __builtin_amdgcn_permlane16_swap(__builtin_bit_cast(unsigned, v), __builtin_bit_cast(unsigned, v), false, false); return __builtin_bit_cast(float, oddrow ? r[0] : r[1]); }
__device__ __forceinline__ float xor32f(float v, bool upper) { const auto r = __builtin_amdgcn_permlane32_swap(__builtin_bit_cast(unsigned, v), __builtin_bit_cast(unsigned, v), false, false); return __builtin_bit_cast(float, upper ? r[0] : r[1]); }
__device__ __forceinline__ f32x2 idots(const v4u (&R)[16], const v4u& H, int c) {
    int pd[16];
#pragma unroll
    for (int j = 0; j < 16; ++j) { int a = __builtin_amdgcn_sdot4((int)R[j].x, (int)H.x, 0, false); a = __builtin_amdgcn_sdot4((int)R[j].y, (int)H.y, a, false); a = __builtin_amdgcn_sdot4((int)R[j].z, (int)H.z, a, false); a = __builtin_amdgcn_sdot4((int)R[j].w, (int)H.w, a, false); pd[j] = a; }
    int w8[8], w4[4], w2[2];
    { const bool up = (c & 4) != 0;
#pragma unroll
      for (int j = 0; j < 8; ++j) { const int send = up ? pd[j] : pd[8 + j]; const int keep = up ? pd[8 + j] : pd[j]; w8[j] = keep + dppi<0x141>(send); } }
    { const bool up = (c & 2) != 0;
#pragma unroll
      for (int j = 0; j < 4; ++j) { const int send = up ? w8[j] : w8[4 + j]; const int keep = up ? w8[4 + j] : w8[j]; w4[j] = keep + dppi<0x4E>(send); } }
    { const bool up = (c & 1) != 0;
#pragma unroll
      for (int j = 0; j < 2; ++j) { const int send = up ? w4[j] : w4[2 + j]; const int keep = up ? w4[2 + j] : w4[j]; w2[j] = keep + dppi<0xB1>(send); } }
    return (f32x2){(float)w2[0], (float)w2[1]};
}
__device__ __forceinline__ f32x2 axpys(const v4u (&R)[16], const v4u& c0, const v4u& c1, int g) {
    const unsigned cw[8] = {c0.x, c0.y, c0.z, c0.w, c1.x, c1.y, c1.z, c1.w};
    float cf[16];
#pragma unroll
    for (int k = 0; k < 8; ++k) { cf[2 * k] = bflo(cw[k]); cf[2 * k + 1] = bfhi(cw[k]); }
    float acc[16];
#pragma unroll
    for (int k = 0; k < 16; ++k) acc[k] = 0.f;
#pragma unroll
    for (int j = 0; j < 16; ++j) {
#pragma unroll
        for (int w = 0; w < 4; ++w) { const unsigned vw = R[j][w]; const f32x2 lo = __builtin_amdgcn_cvt_pk_f32_fp8((int)vw, false), hh = __builtin_amdgcn_cvt_pk_f32_fp8((int)vw, true);
            acc[4 * w] += cf[j] * lo[0]; acc[4 * w + 1] += cf[j] * lo[1]; acc[4 * w + 2] += cf[j] * hh[0]; acc[4 * w + 3] += cf[j] * hh[1]; } if ((j & 3) == 3) __builtin_amdgcn_sched_barrier(0); }
    float w8[8], w4[4], w2[2];
    { const bool up = (g & 4) != 0;
#pragma unroll
      for (int j = 0; j < 8; ++j) { const float send = up ? acc[j] : acc[8 + j]; const float keep = up ? acc[8 + j] : acc[j]; w8[j] = keep + xor32f(send, up); } }
    { const bool up = (g & 2) != 0;
#pragma unroll
      for (int j = 0; j < 4; ++j) { const float send = up ? w8[j] : w8[4 + j]; const float keep = up ? w8[4 + j] : w8[j]; w4[j] = keep + xor16f(send, up); } }
    { const bool up = (g & 1) != 0;
#pragma unroll
      for (int j = 0; j < 2; ++j) { const float send = up ? w4[j] : w4[2 + j]; const float keep = up ? w4[2 + j] : w4[j]; w2[j] = keep + dppf<0x128>(send); } }
    return (f32x2){w2[0], w2[1]};
}
}

struct Frame {
    LAS unsigned char* lds; volatile LAS unsigned* MISC; gu32* ctl;
    int tid, lane, wave, vcu, G;
};
struct Args { const void* in[19]; float* out; unsigned char* ws; int ph_lo, ph_hi, dry, pad; };

__device__ __forceinline__ void p0_transpose_item(const float* W, int K, int N, bf16* WT, int k0, int n0, int drow0, const float* gain, LAS float* scr, int lane) {
    float wv_[32];
#pragma unroll
    for (int i = 0; i < 32; ++i) { const int kk = 2 * i + (lane >> 5); wv_[i] = W[(size_t)(k0 + kk) * N + n0 + (lane & 31)]; }
    if (gain) {
#pragma unroll
        for (int i = 0; i < 32; ++i) { const int kk = 2 * i + (lane >> 5); wv_[i] *= gain[k0 + kk]; } }
#pragma unroll
    for (int i = 0; i < 32; ++i) { const int kk = 2 * i + (lane >> 5); scr[kk * 33 + (lane & 31)] = wv_[i]; }
    LDS_WAIT(); asm volatile("" ::: "memory");
    const int c = lane & 7;
#pragma unroll
    for (int j = 0; j < 4; ++j) { const int n = (lane >> 3) + 8 * j; const LAS float* s = scr + (8 * c) * 33 + n;
        v4u o; o.x = pk2(s[0 * 33], s[1 * 33]); o.y = pk2(s[2 * 33], s[3 * 33]); o.z = pk2(s[4 * 33], s[5 * 33]); o.w = pk2(s[6 * 33], s[7 * 33]);
        *(v4u*)(WT + (size_t)(drow0 + n) * K + k0 + 8 * c) = o; }
    LDS_WAIT(); asm volatile("" ::: "memory");
}

#define Xin ((const float*)args.in[0])
#define cin ((const float*)args.in[1])
#define POSin ((const int*)args.in[2])
#define w_ada ((const float*)args.in[3])
#define b_ada ((const float*)args.in[4])
#define g_mix ((const float*)args.in[5])
#define w_in ((const float*)args.in[6])
#define g_qa ((const float*)args.in[7])
#define w_uq ((const float*)args.in[8])
#define g_kva ((const float*)args.in[9])
#define w_ukv ((const float*)args.in[10])
#define rel_bias ((const float*)args.in[11])
#define w_out ((const float*)args.in[12])
#define g_ffn ((const float*)args.in[13])
#define w_pq ((const float*)args.in[14])
#define peer_keys ((const float*)args.in[15])
#define peer_u ((const float*)args.in[16])
#define peer_v ((const float*)args.in[17])
#define g_final ((const float*)args.in[18])
#define Wt_in ((bf16*)(ws + WS_W_IN))
#define Wt_uq ((bf16*)(ws + WS_W_UQ))
#define Wt_ukv ((bf16*)(ws + WS_W_UKV))
#define Wt_out ((bf16*)(ws + WS_W_OUT))
#define Wt_pq ((bf16*)(ws + WS_W_PQ))
#define PU ((unsigned char*)(ws + WS_PU))
#define SU ((float*)(ws + WS_SU))
#define SV ((float*)(ws + WS_SV))
#define PV ((unsigned char*)(ws + WS_PV))
#define HB ((bf16*)(ws + WS_HB))
#define CQ ((bf16*)(ws + WS_CQ))
#define CKV ((bf16*)(ws + WS_CKV))
#define KRF ((float*)(ws + WS_KRF))
#define KRB ((bf16*)(ws + WS_KRB))
#define MQ ((bf16*)(ws + WS_MQ))
#define MK ((bf16*)(ws + WS_MK))
#define MV ((bf16*)(ws + WS_MV))
#define QM ((bf16*)(ws + WS_QM))
#define KN ((bf16*)(ws + WS_KN))
#define VM ((bf16*)(ws + WS_VM))
#define ROPET ((float*)(ws + WS_ROPE))
#define MOD ((float*)(ws + WS_MOD))
#define KMEAN ((float*)(ws + OFF_KSUM))
#define KH ((bf16*)(ws + WS_KH))
#define KL ((bf16*)(ws + WS_KL))
#define SSQ_Q ((float*)(ws + OFF_SSQ_Q))
#define SSQ_KV ((float*)(ws + OFF_SSQ_KV))
#define SSQ_1 ((float*)(ws + OFF_SSQ_1))
#define PQ ((float*)(ws + WS_PQ))
#define EIDX ((int*)(ws + WS_EIDX))
#define EGATE ((float*)(ws + WS_EGATE))
#define COEF ((float*)(ws + WS_COEF))
#define LISTP ((unsigned short*)(ws + WS_LIST))
#define SELM ((unsigned*)(ws + WS_SELM))
#define QPP ((unsigned short*)(ws + WS_QP))
#define POP ((bf16*)((unsigned char*)args.out + PO_OFF))
#define PMLP ((float*)((unsigned char*)args.out + PML_OFF))
#define HQ ((unsigned char*)(ws + WS_HQ))
#define HS ((float*)(ws + WS_HS))
#define ESU ((float*)(ws + WS_ESU))
#define ESV ((float*)(ws + WS_ESV))
#define SSQ_2 ((float*)(ws + OFF_SSQ_2))
#define PA_SLICE(sl) ((bf16*)(ws + WS_PQ + (size_t)(sl) * 8 * MiB))
#define X1 (args.out)
#define X1B ((bf16*)(ws + 45 * MiB))
#define OUTp (args.out)
__device__ __forceinline__ void peer_quant_one(const Args& args, unsigned char* ws, int r, int plane, const f32x4& v0, const f32x4& v1, const f32x4& v2, const f32x4& v3) {
    const int half = r >= 16384, row = r - half * 16384;
    float am = 0.f;
#pragma unroll
    for (int j = 0; j < 4; ++j) am = fmaxf(am, fmaxf(fmaxf(fabsf(v0[j]), fabsf(v1[j])), fmaxf(fabsf(v2[j]), fabsf(v3[j]))));
    am = wave_max(am);
    v4u o4;
    if (half) {
        const float inv = am > 0.f ? 448.0f / am : 0.f; int w;
        w = __builtin_amdgcn_cvt_pk_fp8_f32(v0[0] * inv, v0[1] * inv, 0, false); w = __builtin_amdgcn_cvt_pk_fp8_f32(v0[2] * inv, v0[3] * inv, w, true); o4.x = (unsigned)w;
        w = __builtin_amdgcn_cvt_pk_fp8_f32(v1[0] * inv, v1[1] * inv, 0, false); w = __builtin_amdgcn_cvt_pk_fp8_f32(v1[2] * inv, v1[3] * inv, w, true); o4.y = (unsigned)w;
        w = __builtin_amdgcn_cvt_pk_fp8_f32(v2[0] * inv, v2[1] * inv, 0, false); w = __builtin_amdgcn_cvt_pk_fp8_f32(v2[2] * inv, v2[3] * inv, w, true); o4.z = (unsigned)w;
        w = __builtin_amdgcn_cvt_pk_fp8_f32(v3[0] * inv, v3[1] * inv, 0, false); w = __builtin_amdgcn_cvt_pk_fp8_f32(v3[2] * inv, v3[3] * inv, w, true); o4.w = (unsigned)w;
    } else {
        const float inv = am > 0.f ? 127.0f / am : 0.f;
#define Q8_(v) ((unsigned)(__float2int_rn((v) * inv)) & 0xffu)
        o4.x = Q8_(v0[0]) | (Q8_(v0[1]) << 8) | (Q8_(v0[2]) << 16) | (Q8_(v0[3]) << 24); o4.y = Q8_(v1[0]) | (Q8_(v1[1]) << 8) | (Q8_(v1[2]) << 16) | (Q8_(v1[3]) << 24);
        o4.z = Q8_(v2[0]) | (Q8_(v2[1]) << 8) | (Q8_(v2[2]) << 16) | (Q8_(v2[3]) << 24); o4.w = Q8_(v3[0]) | (Q8_(v3[1]) << 8) | (Q8_(v3[2]) << 16) | (Q8_(v3[3]) << 24);
#undef Q8_
    }
    *(v4u*)((half ? PV : PU) + (size_t)(plane >> 3) * (16384 * 128) + (size_t)row * 128 + (plane & 7) * 16) = o4;
    if (plane == 0) { if (half) SV[row] = am * (1.0f / 448.0f); else SU[row] = am * (1.0f / 127.0f); }
}
__device__ __forceinline__ void peer_quant_rows(const Args& args, unsigned char* ws, int r_lo, int r_hi, int plane) {
    if (r_lo >= r_hi) return;
#define QSRC_(r) (((r) >= 16384 ? peer_v + (size_t)((r) - 16384) * D : peer_u + (size_t)(r) * D) + plane * 16)
#define QLD_(X, r) do { const int rr_ = (r) < r_last ? (r) : r_last; const float* p_ = QSRC_(rr_); X##0 = *(const f32x4*)p_; X##1 = *(const f32x4*)(p_ + 4); X##2 = *(const f32x4*)(p_ + 8); X##3 = *(const f32x4*)(p_ + 12); } while (0)
    const int r_last = r_hi - 1;
    f32x4 a0, a1, a2, a3, b0, b1, b2, b3, c0, c1, c2, c3, d0, d1, d2, d3;
    QLD_(a, r_lo); QLD_(b, r_lo + 1); QLD_(c, r_lo + 2); QLD_(d, r_lo + 3);
#pragma unroll 1
    for (int r = r_lo; r < r_hi; r += 4) {
        peer_quant_one(args, ws, r, plane, a0, a1, a2, a3); QLD_(a, r + 4);
        if (r + 1 < r_hi) peer_quant_one(args, ws, r + 1, plane, b0, b1, b2, b3);
        QLD_(b, r + 5);
        if (r + 2 < r_hi) peer_quant_one(args, ws, r + 2, plane, c0, c1, c2, c3);
        QLD_(c, r + 6);
        if (r + 3 < r_hi) peer_quant_one(args, ws, r + 3, plane, d0, d1, d2, d3);
        QLD_(d, r + 7);
    }
#undef QLD_
#undef QSRC_
}

__global__ void __launch_bounds__(NWAVES * 64, 2) mk_fwd(Args args) {
    extern __shared__ __attribute__((aligned(16))) unsigned char lds_raw[];
    Frame F;
    F.lds = (LAS unsigned char*)lds_raw; F.MISC = (volatile LAS unsigned*)(F.lds + MISC_OFF);
    F.tid = threadIdx.x; F.lane = F.tid & 63; F.wave = __builtin_amdgcn_readfirstlane(F.tid >> 6);
    F.G = gridDim.x; { const int bx = blockIdx.x; F.vcu = (F.G % 8 == 0) ? (bx % 8) * (F.G / 8) + bx / 8 : bx; }
    unsigned char* ws = args.ws; F.ctl = (gu32*)(ws + WS_CTL);
    for (int u = F.tid; u < (LDS_BYTES - LDSCTL_OFF) / 4; u += NWAVES * 64) ((LAS unsigned*)(F.lds + LDSCTL_OFF))[u] = 0u;
    __syncthreads();
    XcdBarrier bar; bar.bar = (unsigned*)(F.ctl + CW_BAR); bar.x = 0; bar.st = nullptr;
    if (MK_LAUNCHES == 1) bar = xcd_barrier_post((unsigned*)(F.ctl + CW_BAR), F.MISC + 8);
    const int lo = args.ph_lo, hi = args.ph_hi;
#ifndef PH_MASK
#define PH_MASK 0x7fff
#endif
#define IN(k) (((PH_MASK >> (k)) & 1) && lo <= (k) && (k) < hi)
#define SEAM(k) do { if (IN(k) && IN((k) + 1)) xcd_barrier(bar); } while (0)
    const int gw = F.vcu * NWAVES + F.wave, NGW = F.G * NWAVES;
    const int NGT = F.G * NWAVES * 64;
#define gt (F.vcu * (NWAVES * 64) + ptid)

    if (IN(0)) {
        const int ptid = opaque_tid(), plane = ptid & 63; (void)plane;
        if (F.vcu < 96) {
            LAS float* sc = (LAS float*)(F.lds);
            LAS float* red = sc + 4096;
            const int kg = plane >> 4, c4 = plane & 15; const float* wp = w_ada + (size_t)F.vcu * 64 + c4 * 4;
            float cv[8]; f32x4 wv[32];
#pragma unroll
            for (int j = 0; j < 8; ++j) cv[j] = cin[ptid + 512 * j];
#pragma unroll
            for (int u = 0; u < 32; ++u) wv[u] = *(const f32x4*)(wp + (size_t)(F.wave * 128 + 4 * u + kg) * 6 * D);
#pragma unroll
            for (int j = 0; j < 8; ++j) sc[ptid + 512 * j] = cv[j] / (1.f + __expf(-cv[j]));
            __syncthreads();
            f32x4 A0 = {0.f, 0.f, 0.f, 0.f}, A1 = A0, A2 = A0, A3 = A0;
#pragma unroll
            for (int u = 0; u < 32; ++u) { const int k = F.wave * 128 + 4 * u + kg; A0 += sc[k] * wv[u]; A1 += sc[1024 + k] * wv[u]; A2 += sc[2048 + k] * wv[u]; A3 += sc[3072 + k] * wv[u]; }
#pragma unroll
            for (int j = 0; j < 4; ++j) { float v0 = A0[j], v1 = A1[j], v2 = A2[j], v3 = A3[j];
                v0 += lane_xor16(v0); v0 += lane_xor32(v0); v1 += lane_xor16(v1); v1 += lane_xor32(v1); v2 += lane_xor16(v2); v2 += lane_xor32(v2); v3 += lane_xor16(v3); v3 += lane_xor32(v3);
                if (kg == 0) { red[(F.wave * 4 + 0) * 64 + c4 * 4 + j] = v0; red[(F.wave * 4 + 1) * 64 + c4 * 4 + j] = v1; red[(F.wave * 4 + 2) * 64 + c4 * 4 + j] = v2; red[(F.wave * 4 + 3) * 64 + c4 * 4 + j] = v3; } }
            __syncthreads();
            if (ptid < 256) { const int bb = ptid >> 6, l = ptid & 63; float s = b_ada[F.vcu * 64 + l];
#pragma unroll
                for (int w = 0; w < 8; ++w) s += red[(w * 4 + bb) * 64 + l];
                __hip_atomic_store(&MOD[bb * 6 * D + F.vcu * 64 + l], s, __ATOMIC_RELAXED, __HIP_MEMORY_SCOPE_AGENT); }
            asm volatile("s_waitcnt vmcnt(0)" ::: "memory");
            __syncthreads();
            if (ptid == 0) __hip_atomic_fetch_add((unsigned*)(F.ctl + CW_MODFLAG), 1u, __ATOMIC_RELEASE, __HIP_MEMORY_SCOPE_AGENT);
        }
        const bool split0 = (F.G == 256);
        const int w2 = split0 ? (F.vcu - 96) * NWAVES + F.wave : gw, nw2 = split0 ? 160 * NWAVES : NGW, t2 = split0 ? (F.vcu - 96) * (NWAVES * 64) + ptid : gt, nt2 = split0 ? 160 * NWAVES * 64 : NGT;
        if (!split0 || F.vcu >= 96) {
        {
            LAS float* scr = (LAS float*)(F.lds + F.wave * 16384);
            constexpr int I_IN = 16 * 81, I_UQ = 12 * 24, I_UKV = 4 * 32, I_OUT = 16 * 32, I_PQ = 16 * 32;
            for (int it = w2; it < I_IN + I_UQ + I_UKV + I_OUT + I_PQ; it += nw2) {
                int r = it;
                if (r < I_IN) { const int kb = r / 81, nb = r % 81, n0 = nb * 32; const int dr = (n0 < 1024) ? n0 : (n0 == 1024 ? 2560 : n0 - 32);
                    p0_transpose_item(w_in, 1024, 2592, Wt_in, kb * 64, n0, dr, nullptr, scr, plane); continue; } r -= I_IN;
                if (r < I_UQ) { const int kb = r / 24, nb = r % 24; p0_transpose_item(w_uq, 768, 768, Wt_uq, kb * 64, nb * 32, nb * 32, g_qa, scr, plane); continue; } r -= I_UQ;
                if (r < I_UKV) { const int kb = r / 32, nb = r % 32; p0_transpose_item(w_ukv, 256, 1024, Wt_ukv, kb * 64, nb * 32, nb * 32, g_kva, scr, plane); continue; } r -= I_UKV;
                if (r < I_OUT) { const int kb = r / 32, nb = r % 32; p0_transpose_item(w_out, 1024, 1024, Wt_out, kb * 64, nb * 32, nb * 32, nullptr, scr, plane); continue; } r -= I_OUT;
                { const int kb = r / 32, nb = r % 32; p0_transpose_item(w_pq, 1024, 1024, Wt_pq, kb * 64, nb * 32, nb * 32, nullptr, scr, plane); }
            }
            for (int i = t2; i < 224 * 1024 / 8; i += nt2) *(v4u*)(Wt_in + (size_t)2592 * 1024 + (size_t)i * 8) = (v4u){0u, 0u, 0u, 0u};
        }
        if (F.G != 256) { const int per = (32768 + NGW - 1) / NGW; const int lo = gw * per, hi = lo + per < 32768 ? lo + per : 32768; peer_quant_rows(args, ws, lo, hi, plane); }
        else {
            const int lo = w2 * QR0B;
            peer_quant_rows(args, ws, lo, lo + QR0B, plane); }
        for (int i = t2; i < 8 * 2 * 128 * 64; i += nt2) { const float v = peer_keys[i]; const unsigned hb = f2bf(v); const float r = v - __builtin_bit_cast(float, hb << 16); KH[i] = (bf16)hb; KL[i] = (bf16)f2bf(r); }
        for (int i = t2; i < T * 16; i += nt2) { const int t = i >> 4, j = i & 15; const float inv = powf(10000.0f, -(float)j / 16.0f); const float ang = (float)POSin[t] * inv;
            ROPET[(size_t)i * 2] = cosf(ang); ROPET[(size_t)i * 2 + 1] = sinf(ang); }
        }
    }
    if (MK_LAUNCHES != 1) { SEAM(0); }
    if (IN(1)) {
        const int ptid = opaque_tid(), plane = ptid & 63; (void)plane;
        const int RPW = (T + NGW - 1) / NGW, m0 = gw * RPW, m1 = (m0 + RPW < T) ? m0 + RPW : T;
        f32x4 vn[4];
        if (m0 < T) { const f32x4* xr = (const f32x4*)(Xin + (size_t)m0 * D) + plane;
#pragma unroll
            for (int j = 0; j < 4; ++j) vn[j] = xr[64 * j]; }
        if (MK_LAUNCHES == 1 && IN(0)) {
            if (ptid == 0) { unsigned sp = 0; while (__hip_atomic_load((unsigned*)(F.ctl + CW_MODFLAG), __ATOMIC_RELAXED, __HIP_MEMORY_SCOPE_AGENT) < 96u) { __builtin_amdgcn_s_sleep(2); if (++sp > (1u << 22)) break; }
                __builtin_amdgcn_fence(__ATOMIC_ACQUIRE, "agent"); asm volatile("s_waitcnt vmcnt(0)" ::: "memory"); }
            __syncthreads();
        }
        int bcur = -1; f32x4 gs[4], shv[4];
#pragma unroll 1
        for (int m = m0; m < m1; ++m) {
            const int b = m / S;
            if (b != bcur) { bcur = b; f32x4 g_[4], sc_[4];
#pragma unroll
                for (int j = 0; j < 4; ++j) { const int c = j * 256 + plane * 4; g_[j] = *(const f32x4*)(g_mix + c); sc_[j] = *(const f32x4*)(MOD + b * 6 * D + D + c); shv[j] = *(const f32x4*)(MOD + b * 6 * D + c); }
#pragma unroll
                for (int j = 0; j < 4; ++j) gs[j] = g_[j] * (sc_[j] + 1.f); }
            f32x4 v[4]; float s = 0.f;
#pragma unroll
            for (int j = 0; j < 4; ++j) v[j] = vn[j];
            { const int mn = m + 1 < m1 ? m + 1 : m; const f32x4* xr = (const f32x4*)(Xin + (size_t)mn * D) + plane;
#pragma unroll
              for (int j = 0; j < 4; ++j) vn[j] = xr[64 * j]; }
#pragma unroll
            for (int j = 0; j < 4; ++j) s += v[j][0] * v[j][0] + v[j][1] * v[j][1] + v[j][2] * v[j][2] + v[j][3] * v[j][3];
            const float rs = 1.0f / sqrtf(wave_sum(s) * (1.f / D) + EPS);
            unsigned long long* o8 = (unsigned long long*)(HB + (size_t)m * D) + plane;
#pragma unroll
            for (int j = 0; j < 4; ++j) { const f32x4 hv = v[j] * rs * gs[j] + shv[j];
                o8[64 * j] = (unsigned long long)pk2(hv[0], hv[1]) | ((unsigned long long)pk2(hv[2], hv[3]) << 32); }
            unsigned long long* x8 = (unsigned long long*)((bf16*)(ws + 45 * MiB) + (size_t)m * D) + plane;
#pragma unroll
            for (int j = 0; j < 4; ++j) x8[64 * j] = (unsigned long long)pk2(v[j][0], v[j][1]) | ((unsigned long long)pk2(v[j][2], v[j][3]) << 32);
        }
    }
    SEAM(1);
    if (IN(2)) {
        const int ptid = opaque_tid(), plane = ptid & 63; (void)plane;
        pg8::Gemm g{HB, Wt_in, T, NZ, D, D}; pg8::StaticOrder So; So.init(T, NZ, F.G, (int)blockIdx.x);
        epi::EpiZ E{ws, args.dry};
        pg8::gemm_phase<epi::EpiZ, pg8::StaticOrder, true, true>(F.lds, g, So, E);
        if (F.G == 256 && blockIdx.x >= 192) { const int hw = ((int)blockIdx.x - 192) * NWAVES + F.wave; peer_quant_rows(args, ws, QROW2 + hw * QR2, QROW2 + (hw + 1) * QR2, plane); }
    }
    SEAM(2);
    if (IN(3)) {
        const int ptid = opaque_tid(), plane = ptid & 63; (void)plane;
        for (int i = gt; i < T * 16; i += NGT) { const int t = i >> 4, j = i & 15; const float cs = ROPET[(size_t)i * 2], sn = ROPET[(size_t)i * 2 + 1];
            const float x1 = KRF[(size_t)t * 32 + j], x2 = KRF[(size_t)t * 32 + 16 + j];
            KRB[(size_t)t * 32 + j] = (bf16)f2bf(x1 * cs - x2 * sn); KRB[(size_t)t * 32 + 16 + j] = (bf16)f2bf(x2 * cs + x1 * sn); }
        { const int lane = plane;
        unsigned* cntp = (unsigned*)(F.ctl + CW_CNT);
        for (int it = gw; it < 32 * 64; it += NGW) {
            const int bh = it >> 6, grp = it & 63, b = bh >> 3, h = bh & 7, q = grp * 64 + lane, qb = (grp * 64) >> 8;
            const size_t tq = (size_t)b * S + q;
            unsigned mask;
            if (qb <= 3) mask = (1u << qb) - 1u;
            else {
                float qf[64];
                { const v4u* qp = (const v4u*)(MQ + tq * 512 + h * 64);
#pragma unroll
                  for (int i = 0; i < 8; ++i) { const v4u w = qp[i]; qf[8 * i] = bflo(w.x); qf[8 * i + 1] = bfhi(w.x); qf[8 * i + 2] = bflo(w.y); qf[8 * i + 3] = bfhi(w.y); qf[8 * i + 4] = bflo(w.z); qf[8 * i + 5] = bfhi(w.z); qf[8 * i + 6] = bflo(w.w); qf[8 * i + 7] = bfhi(w.w); } }
                LAS float* kml = (LAS float*)(F.lds + F.wave * 4096);
                { const f32x4* ksrc = (const f32x4*)(KMEAN + (size_t)(b * 8 + h) * 16 * 64) + lane * 4; f32x4 t0 = ksrc[0], t1 = ksrc[1], t2 = ksrc[2], t3 = ksrc[3];
                  LAS f32x4* kd = (LAS f32x4*)kml + lane * 4; kd[0] = t0; kd[1] = t1; kd[2] = t2; kd[3] = t3; LDS_WAIT(); asm volatile("" ::: "memory"); }
                float v1 = -INFINITY, v2 = -INFINITY, v3 = -INFINITY; int i1 = 0, i2 = 0, i3 = 0;
#pragma unroll 1
                for (int n = 0; n < qb; ++n) { const LAS float* km = kml + n * 64; float a = 0.f;
#pragma unroll
                    for (int d = 0; d < 64; ++d) a += qf[d] * km[d];
                    if (a > v1) { v3 = v2; i3 = i2; v2 = v1; i2 = i1; v1 = a; i1 = n; } else if (a > v2) { v3 = v2; i3 = i2; v2 = a; i2 = n; } else if (a > v3) { v3 = a; i3 = n; } }
                const unsigned mk = (1u << i1) | (1u << i2) | (1u << i3);
                mask = mk;
            }
            SELM[tq * 8 + h] = mask;
            unsigned mycnt = 0;
#pragma unroll
            for (int n = 0; n < 15; ++n) { const unsigned long long bal = __ballot((mask >> n) & 1u); if (lane == n) mycnt = (unsigned)__builtin_popcountll(bal); }
            unsigned mybase = 0;
            if (mycnt) mybase = __hip_atomic_fetch_add(cntp + bh * 16 + lane, mycnt, __ATOMIC_RELAXED, __HIP_MEMORY_SCOPE_AGENT);
#pragma unroll
            for (int n = 0; n < 15; ++n) {
                const bool has = (mask >> n) & 1u; const unsigned long long bal = __ballot(has);
                const unsigned base = (unsigned)__builtin_amdgcn_readlane((int)mybase, n);
                if (has) { const unsigned pos = base + (unsigned)__builtin_popcountll(bal & ((1ull << lane) - 1ull)); const unsigned k = (unsigned)__builtin_popcount(mask & ((1u << n) - 1u));
                    LISTP[((size_t)bh * 15 + n) * LIST_CAP + pos] = (unsigned short)((unsigned)q | (k << 12)); QPP[(tq * 8 + h) * 4 + k] = (unsigned short)pos; }
            }
        }
        }
        __syncthreads();
        if (F.G == 256 && blockIdx.x >= 192) { const int hw = ((int)blockIdx.x - 192) * NWAVES + F.wave; peer_quant_rows(args, ws, QROW3 + hw * QR3, QROW3 + (hw + 1) * QR3, plane); }
        { pg8::Gemm g{CQ, Wt_uq, T, 768, 768, 768}; pg8::StaticOrder So; So.init(T, 768, F.G, (int)blockIdx.x);
          epi::EpiQ E{ws};
          pg8::gemm_phase<epi::EpiQ, pg8::StaticOrder, true, true>(F.lds, g, So, E); }
        { pg8::Gemm g{CKV, Wt_ukv, T, 1024, 256, 256}; pg8::StaticOrder So; So.init(T, 1024, F.G, (int)blockIdx.x);
          epi::EpiKV E{ws};
          pg8::gemm_phase<epi::EpiKV, pg8::StaticOrder, true, true>(F.lds, g, So, E); }
    }
    SEAM(3);
    LAS unsigned* tcnt = (LAS unsigned*)(F.lds + 98304); LAS unsigned* tpb = tcnt + 480; LAS unsigned* tsub = tpb + 480; LAS unsigned* tbc = tsub + 484;
    if (IN(5) || IN(6)) {
        if (IN(5)) {
            for (int v = F.vcu; v < 256; v += F.G) { const int bh = v >> 3, s = v & 7, b = bh >> 3, h = bh & 7;
                if (F.wave < 4) { att::mla_unit2<0>(F.lds, b, h, 15 - s, QM, KN, KRB, VM, ROPET, HB); att::mla_unit2<0>(F.lds, b, h, s, QM, KN, KRB, VM, ROPET, HB); }
                else            { att::mla_unit2<1>(F.lds, b, h, 15 - s, QM, KN, KRB, VM, ROPET, HB); att::mla_unit2<1>(F.lds, b, h, s, QM, KN, KRB, VM, ROPET, HB); } }
        }
        const int ptid = opaque_tid();
        const unsigned* cntp = (const unsigned*)(F.ctl + CW_CNT);
        for (int i = ptid; i < 480; i += 512) tcnt[i] = __hip_atomic_load(cntp + (i / 15) * 16 + (i % 15), __ATOMIC_RELAXED, __HIP_MEMORY_SCOPE_AGENT);
        __syncthreads();
        if (ptid < 64) {
            unsigned c8[8], pb = 0, sp = 0;
#pragma unroll
            for (int j = 0; j < 8; ++j) { const int i = ptid * 8 + j; c8[j] = (i < 480) ? tcnt[i] : 0u; pb += c8[j]; sp += (((c8[j] + 31u) >> 5) + 15u) >> 4; }
            unsigned ipb = pb, isp = sp;
#pragma unroll
            for (int o = 1; o < 64; o <<= 1) { const unsigned a_ = (unsigned)__shfl_up((int)ipb, o), b_ = (unsigned)__shfl_up((int)isp, o); if (ptid >= o) { ipb += a_; isp += b_; } }
            unsigned epb = ipb - pb, esp = isp - sp;
#pragma unroll
            for (int j = 0; j < 8; ++j) { const int i = ptid * 8 + j; if (i < 480) { tpb[i] = epb; tsub[i] = esp; } else if (i == 480) tsub[480] = esp; epb += c8[j]; esp += (((c8[j] + 31u) >> 5) + 15u) >> 4; }
        }
        __syncthreads();
    }
    if (IN(5)) {
        const int ptid = opaque_tid();
        const unsigned NS = tsub[480]; unsigned* qc = (unsigned*)(F.ctl + CW_QCTR2); int last_h = -1;
        unsigned nxt = 0; if (ptid == 0) nxt = __hip_atomic_fetch_add(qc, 1u, __ATOMIC_RELAXED, __HIP_MEMORY_SCOPE_AGENT);
        for (;;) {
            if (ptid == 0) { *tbc = nxt; nxt = __hip_atomic_fetch_add(qc, 1u, __ATOMIC_RELAXED, __HIP_MEMORY_SCOPE_AGENT); }
            __syncthreads();
            const unsigned sidx = *tbc;
            __syncthreads();
            if (sidx >= NS) break;
            int lo_ = 0, hi_ = 480;
            while (hi_ - lo_ > 1) { const int mid = (lo_ + hi_) >> 1; if (tsub[mid] <= sidx) lo_ = mid; else hi_ = mid; }
            const int i = lo_, bh = i / 15, n = i % 15;
            att::moba_past_sub(F.lds, bh >> 3, bh & 7, n, (int)(sidx - tsub[i]), tcnt[i], tpb[i], LISTP + (size_t)i * LIST_CAP, MQ, MK, MV, rel_bias, POP, PMLP, (bh & 7) != last_h); last_h = bh & 7;
        }
    }
    SEAM(5);
    if (IN(6)) {
        att::MergeCtx mc{SELM, QPP, POP, PMLP, tpb, 1};
        for (int v = F.vcu; v < 256; v += F.G) { const int bh = v >> 3, s = v & 7, b = bh >> 3, h = bh & 7;
            mc.fill_table = 1; att::moba_own_unit(F.lds, b, h, 15 - s, MQ, MK, MV, rel_bias, HB, 512, &mc);
            mc.fill_table = 0; att::moba_own_unit(F.lds, b, h, s, MQ, MK, MV, rel_bias, HB, 512, &mc); }
    }
    SEAM(6);
    if (IN(7)) {
        const int ptid = opaque_tid(), plane = ptid & 63; (void)plane;
        pg8::Gemm g{HB, Wt_out, T, D, D, D}; pg8::StaticOrder So; So.init(T, D, F.G, (int)blockIdx.x);
        epi::EpiRes E{Xin, X1B, ws, args.dry};
        pg8::gemm_phase<epi::EpiRes, pg8::StaticOrder, true, true>(F.lds, g, So, E);
    }
    SEAM(7);
    if (IN(8)) {
        const int ptid = opaque_tid(), plane = ptid & 63; (void)plane;
        const int RPW = (T + NGW - 1) / NGW, m0 = gw * RPW, m1 = (m0 + RPW < T) ? m0 + RPW : T;
        v2u vn[4]; float sqn = 0.f;
        if (m0 < T) { const v2u* xr = (const v2u*)(X1B + (size_t)m0 * D) + plane; sqn = SSQ_1[m0];
#pragma unroll
            for (int j = 0; j < 4; ++j) vn[j] = xr[64 * j]; }
        int bcur = -1; f32x4 gs[4], shv[4];
#pragma unroll 1
        for (int m = m0; m < m1; ++m) {
            const int b = m / S;
            if (b != bcur) { bcur = b; f32x4 g_[4], sc_[4];
#pragma unroll
                for (int j = 0; j < 4; ++j) { const int c = j * 256 + plane * 4; g_[j] = *(const f32x4*)(g_ffn + c); sc_[j] = *(const f32x4*)(MOD + b * 6 * D + 4 * D + c); shv[j] = *(const f32x4*)(MOD + b * 6 * D + 3 * D + c); }
#pragma unroll
                for (int j = 0; j < 4; ++j) gs[j] = g_[j] * (sc_[j] + 1.f); }
            const float rs = 1.0f / sqrtf(sqn * (1.f / D) + EPS);
            f32x4 hq[4];
#pragma unroll
            for (int j = 0; j < 4; ++j) { const f32x4 xv_ = {bflo(vn[j].x), bfhi(vn[j].x), bflo(vn[j].y), bfhi(vn[j].y)}; hq[j] = xv_ * rs * gs[j] + shv[j]; }
            { const int mn = m + 1 < m1 ? m + 1 : m; const v2u* xr = (const v2u*)(X1B + (size_t)mn * D) + plane; sqn = SSQ_1[mn];
#pragma unroll
              for (int j = 0; j < 4; ++j) vn[j] = xr[64 * j]; }
            unsigned long long* o8 = (unsigned long long*)(HB + (size_t)m * D) + plane;
#pragma unroll
            for (int j = 0; j < 4; ++j) o8[64 * j] = (unsigned long long)pk2(hq[j][0], hq[j][1]) | ((unsigned long long)pk2(hq[j][2], hq[j][3]) << 32);
            float am = 0.f;
#pragma unroll
            for (int j = 0; j < 4; ++j) am = fmaxf(am, fmaxf(fmaxf(fabsf(hq[j][0]), fabsf(hq[j][1])), fmaxf(fabsf(hq[j][2]), fabsf(hq[j][3]))));
            am = wave_max(am);
            const float qi = am > 0.f ? 127.0f / am : 0.f;
#pragma unroll
            for (int j = 0; j < 4; ++j) { const int c = j * 256 + plane * 4;
                *(unsigned*)(HQ + (size_t)m * D + c) = ((unsigned)__float2int_rn(hq[j][0] * qi) & 0xffu) | (((unsigned)__float2int_rn(hq[j][1] * qi) & 0xffu) << 8) | (((unsigned)__float2int_rn(hq[j][2] * qi) & 0xffu) << 16) | (((unsigned)__float2int_rn(hq[j][3] * qi) & 0xffu) << 24); }
            if (plane == 0) HS[m] = am * (1.0f / 127.0f);
        }
    }
    SEAM(8);
    if (IN(9)) {
        const int ptid = opaque_tid(), plane = ptid & 63; (void)plane;
        pg8::Gemm g{HB, Wt_pq, T, D, D, D}; pg8::StaticOrder So; So.init(T, D, F.G, (int)blockIdx.x);
        epi::EpiF32 E{PQ, D};
        pg8::gemm_phase<epi::EpiF32, pg8::StaticOrder, true, true>(F.lds, g, So, E);
    }
    SEAM(9);
    if (IN(10)) {
        const int ptid = opaque_tid(), plane = ptid & 63; (void)plane;
        const int lane = plane, r32 = lane & 31, hi = lane >> 5;
        LAS unsigned* dl = (LAS unsigned*)(F.lds + F.wave * 4096);
        const int h = F.vcu & 7; LAS unsigned char* khs = F.lds + 32768; LAS unsigned char* kls = khs + 256 * 144;
        { v4u kq[8];
#pragma unroll
          for (int i = 0; i < 8; ++i) { const int pc = ptid + 512 * i; const int tb_ = pc >= 2048, q_ = pc & 2047, row = q_ >> 3, ch = q_ & 7; kq[i] = *(const v4u*)((tb_ ? KL : KH) + ((size_t)(h * 256 + row)) * 64 + ch * 8); }
#pragma unroll
          for (int i = 0; i < 8; ++i) { const int pc = ptid + 512 * i; const int tb_ = pc >= 2048, q_ = pc & 2047, row = q_ >> 3, ch = q_ & 7; *(LAS v4u*)((tb_ ? kls : khs) + row * 144 + ch * 16) = kq[i]; } }
        __syncthreads();
        for (int it2 = 0; it2 < (T / 32) * 8 / (F.G * NWAVES); ++it2) {
            const int t = (((F.vcu >> 3) * ((T / 32) * 8 / (F.G * NWAVES)) + it2) * NWAVES + F.wave) * 32 + r32;
            float s0[16], s1[16];
#pragma unroll
            for (int p = 0; p < 2; ++p) {
                bf16x8 qh[4], ql[4];
#pragma unroll
                for (int ks = 0; ks < 4; ++ks) { const float* qp = PQ + (size_t)t * 1024 + h * 128 + p * 64 + ks * 16 + hi * 8; const f32x4 a = *(const f32x4*)qp, c = *(const f32x4*)(qp + 4);
                    const float qv[8] = {a[0], a[1], a[2], a[3], c[0], c[1], c[2], c[3]};
#pragma unroll
                    for (int j = 0; j < 8; ++j) { const unsigned hb = f2bf(qv[j]); qh[ks][j] = (short)hb; ql[ks][j] = (short)f2bf(qv[j] - __builtin_bit_cast(float, hb << 16)); } }
                float m[16];
                f32x16 accs[4];
#pragma unroll
                for (int nb = 0; nb < 4; ++nb) {
                    f32x16 acc = {};
                    const int ko = (p * 128 + nb * 32 + r32) * 144 + hi * 16;
#pragma unroll
                    for (int ks = 0; ks < 4; ++ks) { const bf16x8 kh = *(const LAS bf16x8*)(khs + ko + ks * 32), kl = *(const LAS bf16x8*)(kls + ko + ks * 32);
                        acc = __builtin_amdgcn_mfma_f32_32x32x16_bf16(kh, qh[ks], acc, 0, 0, 0); acc = __builtin_amdgcn_mfma_f32_32x32x16_bf16(kl, qh[ks], acc, 0, 0, 0); acc = __builtin_amdgcn_mfma_f32_32x32x16_bf16(kh, ql[ks], acc, 0, 0, 0); }
                    accs[nb] = acc;
                }
#pragma unroll
                for (int nb = 0; nb < 4; ++nb) {
                    float v[16];
#pragma unroll
                    for (int r = 0; r < 16; ++r) { const unsigned n = (unsigned)(nb * 32 + (r & 3) + 8 * (r >> 2)) | ((unsigned)hi << 2); const float av = accs[nb][r]; v[r] = __builtin_bit_cast(float, (__builtin_bit_cast(unsigned, av) & ~127u) | n); }
                    srt::sort_desc<16>(v);
                    if (nb == 0) {
#pragma unroll
                        for (int r = 0; r < 16; ++r) m[r] = v[r]; }
                    else srt::merge16(m, v);
                }
                srt::merge_partner(m, hi != 0);
#pragma unroll
                for (int r = 0; r < 16; ++r) { if (p == 0) s0[r] = m[r]; else s1[r] = m[r]; }
            }
            float c0[16], c1[16];
            srt::cand_fill<0>(s0, s1, hi, c0, c1);
            srt::sort_desc<16>(c0); srt::sort_desc<16>(c1); srt::merge16(c0, c1); srt::merge_partner(c0, hi != 0);
            if (hi) {
#pragma unroll
                for (int k = 0; k < 16; ++k) dl[(16 + k) * 32 + r32] = __builtin_bit_cast(unsigned, s1[k]) & 127u;
            } else {
#pragma unroll
                for (int k = 0; k < 16; ++k) dl[k * 32 + r32] = __builtin_bit_cast(unsigned, s0[k]) & 127u;
            }
            LDS_WAIT();
            if (hi) {
                float e[16]; float sum = 0.f;
#pragma unroll
                for (int k = 0; k < 16; ++k) { e[k] = __expf(c0[k] - c0[0]); sum += e[k]; }
                const float inv = 1.0f / sum; float* gp = EGATE + (size_t)t * 128 + h * 16;
#pragma unroll
                for (int k = 0; k < 4; ++k) *(f32x4*)(gp + 4 * k) = (f32x4){e[4 * k] * inv, e[4 * k + 1] * inv, e[4 * k + 2] * inv, e[4 * k + 3] * inv};
            } else {
                unsigned ex[16];
#pragma unroll
                for (int k = 0; k < 16; ++k) { const unsigned code = __builtin_bit_cast(unsigned, c0[k]) & 255u; ex[k] = dl[(code >> 4) * 32 + r32] * 128u + dl[(16 + (code & 15u)) * 32 + r32]; }
                int* ep = EIDX + (size_t)t * 128 + h * 16;
#pragma unroll
                for (int k = 0; k < 4; ++k) *(v4u*)(ep + 4 * k) = (v4u){ex[4 * k], ex[4 * k + 1], ex[4 * k + 2], ex[4 * k + 3]};
            }
            LDS_WAIT();
        }
    }
    SEAM(10);
    int my_slice = (int)(blockIdx.x & 7), my_rank = (int)(blockIdx.x >> 3);
    if (MK_LAUNCHES == 1 && (IN(11) || IN(13)) && (F.G & 7) == 0) {
        unsigned pre = 0;
        for (unsigned j = 0; j < 16; ++j) { const unsigned c = xb_ld(&bar.bar[XB_XCNT(j)]); if (j < bar.x) pre += c; }
        const int vid = (int)(pre + F.MISC[10]); my_slice = vid / (F.G >> 3); my_rank = vid % (F.G >> 3);
        if (my_slice > 7) { my_slice = (int)(blockIdx.x & 7); my_rank = (int)(blockIdx.x >> 3); }
    }
    my_slice = __builtin_amdgcn_readfirstlane(my_slice); my_rank = __builtin_amdgcn_readfirstlane(my_rank);
    const int NPER = F.G >> 3;
    if (IN(11)) {
        const int ptid = opaque_tid(), lane = ptid & 63, g = lane >> 3, c = lane & 7;
        const unsigned char* pus = PU + (size_t)my_slice * (16384 * 128); const unsigned lo16 = (unsigned)c * 16u; bf16* pa = PA_SLICE(my_slice);
        const int TPB = T / NPER, NTK = TPB / NWAVES; const int tb = my_rank * TPB + F.wave;
        const int col0 = my_slice * 128 + c * 16;
#define P9_H(HV, tt) do { HV[0] = *(const v4u*)(HQ + (size_t)(tt) * D + col0); } while (0)
#define P9_DO(R, HV, tt) do { const f32x2 r2_ = peer::idots(R, HV[0], c); *(unsigned*)(pa + (size_t)(tt) * 128 + g * 16 + 2 * c) = pk2(r2_[0], r2_[1]); } while (0)
        LAS unsigned char* slot = F.lds + F.wave * 16384;
        v4u RA[16], RB[16]; v4u HE[2], HO[2], HC[2];
        const int tle = tb + 8 * (NTK - 2), tlo = tb + 8 * (NTK - 1);
        peer::Idx Ie = peer::load_idx(EIDX, tb, g), Io = peer::load_idx(EIDX, tb + 8, g);
        peer::load_rows(RA, Ie, pus, lo16); P9_H(HE, tb);
        peer::dma_rows(slot, Io, pus, lo16); P9_H(HO, tb + 8);
        Ie = peer::load_idx(EIDX, (tb + 16 < tle ? tb + 16 : tle), g);
#pragma unroll 1
        for (int k = 0; k < NTK; k += 2) {
            const int te = tb + 8 * k, to = te + 8; const int te2 = te + 16 < tle ? te + 16 : tle, to2 = to + 16 < tlo ? to + 16 : tlo, te4 = te + 32 < tle ? te + 32 : tle;
            P9_DO(RA, HE, te);
            Io = peer::load_idx(EIDX, to2, g);
            peer::load_rows(RA, Ie, pus, lo16); P9_H(HE, te2);
            asm volatile("s_waitcnt vmcnt(16)" ::: "memory");
            peer::read_slot(RB, slot, lane); HC[0] = HO[0];
            LDS_WAIT();
            peer::dma_rows(slot, Io, pus, lo16); P9_H(HO, to2); Ie = peer::load_idx(EIDX, te4, g);
            P9_DO(RB, HC, to);
        }
        VM_WAIT();
#undef P9_H
#undef P9_DO
    }
    SEAM(11);
    if (IN(12)) {
        const int ptid = opaque_tid();
        const int i0 = F.vcu * (NWAVES * 64) + ptid, istep = F.G * NWAVES * 64;
        v4u e4 = {0u, 0u, 0u, 0u}; if (i0 < T * 128 / 4) e4 = *((const v4u*)EIDX + i0);
        LAS float* sul = (LAS float*)F.lds; LAS float* svl = sul + 16384;
        { f32x4 tu[8], tv[8];
#pragma unroll
          for (int j = 0; j < 8; ++j) { tu[j] = *((const f32x4*)SU + ptid + 512 * j); tv[j] = *((const f32x4*)SV + ptid + 512 * j); }
#pragma unroll
          for (int j = 0; j < 8; ++j) { *((LAS f32x4*)sul + ptid + 512 * j) = tu[j]; *((LAS f32x4*)svl + ptid + 512 * j) = tv[j]; } }
        __syncthreads();
#pragma unroll 1
        for (int i = i0; i < T * 128 / 4; i += istep) {
            const int in_ = i + istep < T * 128 / 4 ? i + istep : i;
            const v4u e4n = *((const v4u*)EIDX + in_);
            const unsigned ex = e4.x, ey = e4.y, ez = e4.z, ew = e4.w;
            const f32x4 su = {sul[ex], sul[ey], sul[ez], sul[ew]}, sv = {svl[ex], svl[ey], svl[ez], svl[ew]}, gt4 = *((const f32x4*)EGATE + i); const float hs = HS[i >> 5];
            f32x4 a = {0.f, 0.f, 0.f, 0.f};
#pragma unroll
            for (int sl = 0; sl < 8; ++sl) { const v2u w = *((const v2u*)PA_SLICE(sl) + i); const unsigned w0 = w.x, w1 = w.y; a += (f32x4){bflo(w0), bfhi(w0), bflo(w1), bfhi(w1)}; }
            f32x4 o;
#pragma unroll
            for (int q = 0; q < 4; ++q) { const float x_ = a[q] * su[q] * hs; o[q] = 0.5f * x_ * (1.f + erff(x_ * 0.70710678118654752f)) * gt4[q] * sv[q]; }
            *((v2u*)COEF + i) = (v2u){pk2(o[0], o[1]), pk2(o[2], o[3])};
            e4 = e4n;
        }
    }
    SEAM(12);
    if (IN(13)) {
        const int ptid = opaque_tid(), lane = ptid & 63, g = lane >> 3, c = lane & 7;
        const unsigned char* pvs = PV + (size_t)my_slice * (16384 * 128); const unsigned lo16 = (unsigned)c * 16u;
        const int TPB = T / NPER, NTK = TPB / NWAVES; const int tb = my_rank * TPB + F.wave; const int bb = (my_rank * TPB) / S;
        const int col = my_slice * 128 + c * 16 + 2 * g;
        const f32x2 gt2 = *(const f32x2*)(MOD + bb * 6 * D + 5 * D + col);
#define P11_C(CV, XO, tt) do { const v4u* cp_ = (const v4u*)((const bf16*)COEF + (size_t)(tt) * 128 + g * 16); CV[0] = cp_[0]; CV[1] = cp_[1]; XO = *(const unsigned*)(X1B + (size_t)(tt) * D + col); } while (0)
#define P11_DO(R, CV, XO, tt) do { const f32x2 w_ = peer::axpys(R, CV[0], CV[1], g); const f32x2 xn_ = {bflo(XO) + gt2[0] * w_[0], bfhi(XO) + gt2[1] * w_[1]}; \
            *(unsigned*)(X1B + (size_t)(tt) * D + col) = pk2(xn_[0], xn_[1]); } while (0)
        LAS unsigned char* slot = F.lds + F.wave * 16384;
        v4u R[16]; peer::Idx X0, X1i, X2; v4u CC0[2], CC1[2], CC2[2]; unsigned OO0, OO1, OO2;
#define ALD4_(dst, ptr, off) asm volatile("global_load_dwordx4 %0, %1, off offset:" #off : "=&v"(dst) : "v"(ptr) : "memory")
#define ALD2_(dst, ptr) asm volatile("global_load_dword %0, %1, off" : "=&v"(dst) : "v"(ptr) : "memory")
#define LIDX_(X, tt) do { const int* ip_ = EIDX + (size_t)(tt) * 128 + g * 16; ALD4_(X.a, ip_, 0); ALD4_(X.b, ip_, 16); ALD4_(X.c, ip_, 32); ALD4_(X.d, ip_, 48); } while (0)
#define LCX_(CV, XO, tt) do { const bf16* cp_ = (const bf16*)COEF + (size_t)(tt) * 128 + g * 16; ALD4_(CV[0], cp_, 0); ALD4_(CV[1], cp_, 16); const bf16* xp_ = X1B + (size_t)(tt) * D + col; ALD2_(XO, xp_); } while (0)
#define TOK_(k_) (tb + 8 * ((k_) < NTK ? (k_) : NTK - 1))
        LIDX_(X0, TOK_(0)); LIDX_(X1i, TOK_(1)); LCX_(CC0, OO0, TOK_(0));
        asm volatile("s_waitcnt vmcnt(0)" : "+v"(X0.a), "+v"(X0.b), "+v"(X0.c), "+v"(X0.d), "+v"(X1i.a), "+v"(X1i.b), "+v"(X1i.c), "+v"(X1i.d), "+v"(CC0[0]), "+v"(CC0[1]), "+v"(OO0) :: "memory");
        peer::dma_rows(slot, X0, pvs, lo16);
        LIDX_(X2, TOK_(2)); LCX_(CC1, OO1, TOK_(1));
        asm volatile("s_waitcnt vmcnt(7)" ::: "memory");
#define P13_SLOT(XN, XF, CF, OF, CU, OU, XNn, CUn, OUn, kk) do { const int k_ = (kk); peer::read_slot(R, slot, lane); LDS_WAIT(); \
            peer::dma_rows(slot, XN, pvs, lo16); LIDX_(XF, TOK_(k_ + 3)); LCX_(CF, OF, TOK_(k_ + 2)); \
            if (k_ < NTK) P11_DO(R, CU, OU, TOK_(k_)); \
            asm volatile("s_waitcnt vmcnt(7)" : "+v"(XNn.a), "+v"(XNn.b), "+v"(XNn.c), "+v"(XNn.d), "+v"(CUn[0]), "+v"(CUn[1]), "+v"(OUn) :: "memory"); } while (0)
#pragma unroll 1
        for (int k = 0; k < NTK; k += 3) {
            P13_SLOT(X1i, X0, CC2, OO2, CC0, OO0, X2, CC1, OO1, k);
            P13_SLOT(X2, X1i, CC0, OO0, CC1, OO1, X0, CC2, OO2, k + 1);
            P13_SLOT(X0, X2, CC1, OO1, CC2, OO2, X1i, CC0, OO0, k + 2);
        }
        VM_WAIT();
#undef P13_SLOT
#undef TOK_
#undef LIDX_
#undef LCX_
#undef ALD4_
#undef ALD2_
#undef P11_C
#undef P11_DO
    }
    SEAM(13);
    if (IN(14)) {
        const int ptid = opaque_tid(), lane = ptid & 63;
        f32x4 gg[4]; v2u vn[4];
#pragma unroll
        for (int j = 0; j < 4; ++j) gg[j] = *((const f32x4*)g_final + lane + 64 * j);
        const int RPW = (T + NGW - 1) / NGW, m0 = gw * RPW, m1 = (m0 + RPW < T) ? m0 + RPW : T;
        if (m0 < T) { const v2u* xq = (const v2u*)(X1B + (size_t)m0 * D) + lane;
#pragma unroll
            for (int j = 0; j < 4; ++j) vn[j] = xq[64 * j]; }
#pragma unroll 1
        for (int m = m0; m < m1; ++m) {
            f32x4* xr = (f32x4*)(OUTp + (size_t)m * D) + lane; f32x4 v[4]; float ss = 0.f;
#pragma unroll
            for (int j = 0; j < 4; ++j) v[j] = (f32x4){bflo(vn[j].x), bfhi(vn[j].x), bflo(vn[j].y), bfhi(vn[j].y)};
            if (m + 1 < m1) { const v2u* xq = (const v2u*)(X1B + (size_t)(m + 1) * D) + lane;
#pragma unroll
              for (int j = 0; j < 4; ++j) vn[j] = xq[64 * j]; }
#pragma unroll
            for (int j = 0; j < 4; ++j) ss += v[j][0] * v[j][0] + v[j][1] * v[j][1] + v[j][2] * v[j][2] + v[j][3] * v[j][3];
            const float rr = 1.0f / sqrtf(wave_sum(ss) * (1.f / D) + EPS);
            if (!args.dry)
#pragma unroll
            for (int j = 0; j < 4; ++j) xr[64 * j] = v[j] * rr * gg[j];
        }
    }
#undef IN
#undef SEAM
#undef gt
}

extern "C" void kernel_launch(void* const* d_in, const int* in_sizes, int n_in, void* d_out, int out_size, void* d_ws, size_t ws_size, hipStream_t stream) {
    static int grid = 0;
    if (grid == 0) {
        int dev = 0, cus = 0, per_cu = 0;
        if (n_in != 19 || out_size != T * D || ws_size < WS_END) { fprintf(stderr, "kernel_launch: unexpected shapes (n_in %d out %d ws %zu)\n", n_in, out_size, ws_size); grid = -1; return; }
        if (hipGetDevice(&dev) != hipSuccess || hipDeviceGetAttribute(&cus, hipDeviceAttributeMultiprocessorCount, dev) != hipSuccess) { grid = -1; return; }
        if (hipFuncSetAttribute((const void*)mk_fwd, hipFuncAttributeMaxDynamicSharedMemorySize, LDS_BYTES) != hipSuccess) { fprintf(stderr, "kernel_launch: hipFuncSetAttribute failed\n"); grid = -1; return; }
        if (hipOccupancyMaxActiveBlocksPerMultiprocessor(&per_cu, (const void*)mk_fwd, NWAVES * 64, LDS_BYTES) != hipSuccess || per_cu < 1) { fprintf(stderr, "kernel_launch: occupancy query says %d blocks per CU\n", per_cu); per_cu = 1; }
        (void)hipGetLastError();
        grid = cus;
        if (grid > 256) grid = 256;
    }
    if (grid < 0) return;
    if (hipMemsetAsync((char*)d_ws + WS_CTL, 0, CTL_ZERO_BYTES, stream) != hipSuccess) return;
    Args a{};
    for (int i = 0; i < 19; ++i) a.in[i] = d_in[i];
    a.out = (float*)d_out; a.ws = (unsigned char*)d_ws;
    if (MK_LAUNCHES == 1) { a.ph_lo = 0; a.ph_hi = NPHASE; hipLaunchKernelGGL(mk_fwd, dim3(grid), dim3(NWAVES * 64), LDS_BYTES, stream, a); }
    else for (int p = 0; p < NPHASE; ++p) { a.ph_lo = p; a.ph_hi = p + 1;
#ifdef REP_PHASE
        if (p == REP_PHASE) { a.dry = 1; hipLaunchKernelGGL(mk_fwd, dim3(grid), dim3(NWAVES * 64), LDS_BYTES, stream, a); a.dry = 0; }
#endif
        hipLaunchKernelGGL(mk_fwd, dim3(grid), dim3(NWAVES * 64), LDS_BYTES, stream, a); }
}
```
